# Optimizing an MI355X kernel written in HIP

```python
import math
import jax, jax.numpy as jnp
from jax import lax
import numpy as np

D_MODEL = 2048
BATCH = 1
SEQ = 16384
DEPTH = 2

S5_WIDTH = D_MODEL // 4
S5_GROUP = 16
S5_GROUPS = S5_WIDTH // S5_GROUP
S5_STATE = 64
S5_DT_MIN = 1e-3
S5_DT_MAX = 1e-1
POOL_WIDTH = D_MODEL // 4
POOL_WINDOWS = (2, 4, 8, 16)
POOL_NGROUPS = len(POOL_WINDOWS)
POOL_GROUP = POOL_WIDTH // POOL_NGROUPS
GLA_HEADS = 4
GLA_V_WIDTH = D_MODEL // 2
GLA_K_WIDTH = GLA_V_WIDTH // 2
GLA_DK = GLA_K_WIDTH // GLA_HEADS
GLA_DV = GLA_V_WIDTH // GLA_HEADS
GLA_GATE_RANK = 16
GLA_TAU = 16.0
GLA_CHUNK = 64
MIX_WIDTH = S5_WIDTH + POOL_WIDTH + GLA_V_WIDTH
IN_SPLITS = (S5_WIDTH, POOL_WIDTH, GLA_K_WIDTH, GLA_K_WIDTH, GLA_V_WIDTH, GLA_GATE_RANK, GLA_V_WIDTH)
IN_WIDTH = sum(IN_SPLITS)
D_FF = 5632
CONV_WIDTH = 3
PLE_DIM = 256
EPS = 1e-6

kernel_name = "hymba_s5_pool_gla_hybrid"


def rmsnorm(x, w):
    xf = x.astype(jnp.float32)
    y = xf * lax.rsqrt(jnp.mean(xf * xf, axis=-1, keepdims=True) + EPS) * w.astype(jnp.float32)
    return y.astype(x.dtype)


def _linear_recurrence_op(e1, e2):
    a1, b1 = e1
    a2, b2 = e2
    return a1 * a2, a2 * b1 + b2


def s5_mixer(u, a_re, a_im, log_dt, b_re, b_im, c_re, c_im, d_skip, w_glu, b_glu):
    bsz, L, _ = u.shape
    uf = u.astype(jnp.float32).reshape(bsz, L, S5_GROUPS, S5_GROUP)
    A = lax.complex(a_re.astype(jnp.float32), a_im.astype(jnp.float32))
    dt = jnp.exp(log_dt.astype(jnp.float32))[:, None]
    A_bar = jnp.exp(A * dt)
    Bm = lax.complex(b_re.astype(jnp.float32), b_im.astype(jnp.float32))
    B_bar = ((A_bar - 1.0) / A)[..., None] * Bm
    Bu = jnp.einsum('blgc,gnc->blgn', uf.astype(jnp.complex64), B_bar)
    a = jnp.broadcast_to(A_bar, Bu.shape)
    _, states = lax.associative_scan(_linear_recurrence_op, (a, Bu), axis=1)
    Cm = lax.complex(c_re.astype(jnp.float32), c_im.astype(jnp.float32))
    y = jnp.einsum('blgn,gcn->blgc', states, Cm).real
    y = y + d_skip.astype(jnp.float32).reshape(S5_GROUPS, S5_GROUP) * uf
    y = jax.nn.gelu(y.reshape(bsz, L, S5_WIDTH))
    glu = jax.nn.sigmoid(y @ w_glu.astype(jnp.float32) + b_glu.astype(jnp.float32))
    return (y * glu).astype(u.dtype)


def pool_mixer(z, w_pool, pool_scale):
    bsz, L, _ = z.shape
    zf = z.astype(jnp.float32).reshape(bsz, L, POOL_NGROUPS, POOL_GROUP)
    csum = lax.cumsum(zf, axis=1)
    cpad = jnp.pad(csum, ((0, 0), (1, 0), (0, 0), (0, 0)))
    pos = jnp.arange(1, L + 1, dtype=jnp.float32)[None, :, None]
    outs = []
    for gi, w in enumerate(POOL_WINDOWS):
        hi = cpad[:, 1:, gi]
        lo = jnp.pad(cpad[:, :L + 1 - w, gi], ((0, 0), (w - 1, 0), (0, 0)))
        count = jnp.minimum(pos, float(w))
        outs.append((hi - lo) / count)
    pooled = jnp.stack(outs, axis=2) - zf
    mixed = jnp.einsum('blgc,gcd->blgd', pooled, w_pool.astype(jnp.float32))
    mixed = mixed.reshape(bsz, L, POOL_WIDTH) * pool_scale.astype(jnp.float32)
    return mixed.astype(z.dtype)


def gla_chunked(q, k, v, g):
    bsz, L, H, dk = q.shape
    dv = v.shape[-1]
    n = L // GLA_CHUNK

    def to_chunks(t):
        return t.reshape(bsz, n, GLA_CHUNK, H, t.shape[-1]).transpose(0, 3, 1, 2, 4)

    q, k, v, g = to_chunks(q) * (dk ** -0.5), to_chunks(k), to_chunks(v), to_chunks(g)
    b = jnp.cumsum(g, axis=3)
    b_last = b[:, :, :, -1:, :]
    q_dec = q * jnp.exp(b)
    k_dec = k * jnp.exp(-b)
    scores = jnp.einsum('bhntd,bhnsd->bhnts', q_dec, k_dec)
    causal = jnp.tril(jnp.ones((GLA_CHUNK, GLA_CHUNK), dtype=bool))
    scores = jnp.where(causal, scores, 0.0)
    o_intra = jnp.einsum('bhnts,bhnsv->bhntv', scores, v)
    kv_chunk = jnp.einsum('bhnsd,bhnsv->bhndv', k * jnp.exp(b_last - b), v)
    chunk_decay = jnp.exp(b_last[:, :, :, 0, :])

    def step(S, inp):
        dec, kv_n = inp
        return dec[..., None] * S + kv_n, S

    S0 = jnp.zeros((bsz, H, dk, dv), dtype=jnp.float32)
    _, S_prev = lax.scan(step, S0, (chunk_decay.transpose(2, 0, 1, 3), kv_chunk.transpose(2, 0, 1, 3, 4)))
    S_prev = S_prev.transpose(1, 2, 0, 3, 4)
    o_inter = jnp.einsum('bhntd,bhndv->bhntv', q_dec, S_prev)
    o = o_intra + o_inter
    return o.transpose(0, 2, 3, 1, 4).reshape(bsz, L, H, dv)


def gla_mixer(q, k, v, g_lr, r, w_a2, b_a, norm_w):
    bsz, L, _ = q.shape
    f32 = jnp.float32
    qh = q.astype(f32).reshape(bsz, L, GLA_HEADS, GLA_DK)
    kh = k.astype(f32).reshape(bsz, L, GLA_HEADS, GLA_DK)
    vh = v.astype(f32).reshape(bsz, L, GLA_HEADS, GLA_DV)
    logit = g_lr.astype(f32) @ w_a2.astype(f32) + b_a.astype(f32)
    log_alpha = (jax.nn.log_sigmoid(logit) / GLA_TAU).reshape(bsz, L, GLA_HEADS, GLA_DK)
    o = gla_chunked(qh, kh, vh, log_alpha)
    o = rmsnorm(o, norm_w).reshape(bsz, L, GLA_V_WIDTH)
    return (o * jax.nn.silu(r.astype(f32))).astype(q.dtype)


def conv_glu_ffn(a, w_up, conv_w, conv_b, w_down):
    L = a.shape[1]
    up = a @ w_up
    gate, val = up[..., :D_FF], up[..., D_FF:]
    gp = jnp.pad(gate, ((0, 0), (CONV_WIDTH - 1, 0), (0, 0)))
    gc = conv_b
    for j in range(CONV_WIDTH):
        gc = gc + gp[:, j:j + L] * conv_w[j]
    return (jax.nn.silu(gc) * val) @ w_down


def setup_inputs(seed: int = 0) -> dict:
    key = jax.random.key(seed)
    ks = jax.random.split(key, 32)
    f32 = jnp.float32

    def nrm(k, shape, scale):
        return jax.random.normal(k, shape, f32) * scale

    def gain(k, shape):
        return 1.0 + 0.02 * jax.random.normal(k, shape, f32)

    n_idx = jnp.arange(S5_STATE, dtype=f32)
    a_re = -0.5 + 0.01 * jax.random.normal(ks[4], (DEPTH, S5_GROUPS, S5_STATE), f32)
    a_im = math.pi * n_idx + 0.01 * jax.random.normal(ks[5], (DEPTH, S5_GROUPS, S5_STATE), f32)
    log_dt = jax.random.uniform(ks[6], (DEPTH, S5_GROUPS), f32, math.log(S5_DT_MIN), math.log(S5_DT_MAX))
    return {
        "x": nrm(ks[0], (BATCH, SEQ, D_MODEL), 1.0),
        "p": nrm(ks[1], (DEPTH, BATCH, SEQ, PLE_DIM), 1.0),
        "norm_mix_w": gain(ks[2], (DEPTH, D_MODEL)),
        "w_in": nrm(ks[3], (DEPTH, D_MODEL, IN_WIDTH), D_MODEL ** -0.5),
        "s5_a_re": a_re,
        "s5_a_im": a_im,
        "s5_log_dt": log_dt,
        "s5_b_re": nrm(ks[7], (DEPTH, S5_GROUPS, S5_STATE, S5_GROUP), (2 * S5_GROUP) ** -0.5),
        "s5_b_im": nrm(ks[8], (DEPTH, S5_GROUPS, S5_STATE, S5_GROUP), (2 * S5_GROUP) ** -0.5),
        "s5_c_re": nrm(ks[9], (DEPTH, S5_GROUPS, S5_GROUP, S5_STATE), S5_STATE ** -0.5),
        "s5_c_im": nrm(ks[10], (DEPTH, S5_GROUPS, S5_GROUP, S5_STATE), S5_STATE ** -0.5),
        "s5_d": nrm(ks[11], (DEPTH, S5_WIDTH), 1.0),
        "s5_w_glu": nrm(ks[12], (DEPTH, S5_WIDTH, S5_WIDTH), S5_WIDTH ** -0.5),
        "s5_b_glu": nrm(ks[13], (DEPTH, S5_WIDTH), 0.02),
        "pool_w": nrm(ks[14], (DEPTH, POOL_NGROUPS, POOL_GROUP, POOL_GROUP), POOL_GROUP ** -0.5),
        "pool_scale": gain(ks[15], (DEPTH, POOL_WIDTH)),
        "gla_w_a2": nrm(ks[16], (DEPTH, GLA_GATE_RANK, GLA_K_WIDTH), GLA_GATE_RANK ** -0.5),
        "gla_b_a": nrm(ks[17], (DEPTH, GLA_K_WIDTH), 0.1),
        "gla_norm_w": gain(ks[18], (DEPTH, GLA_DV)),
        "w_out": nrm(ks[19], (DEPTH, MIX_WIDTH, D_MODEL), MIX_WIDTH ** -0.5),
        "norm_ffn_w": gain(ks[20], (DEPTH, D_MODEL)),
        "w_up": nrm(ks[21], (DEPTH, D_MODEL, 2 * D_FF), D_MODEL ** -0.5),
        "conv_w": nrm(ks[22], (DEPTH, CONV_WIDTH, D_FF), CONV_WIDTH ** -0.5),
        "conv_b": nrm(ks[23], (DEPTH, D_FF), 0.02),
        "w_down": nrm(ks[24], (DEPTH, D_FF, D_MODEL), D_FF ** -0.5),
        "norm_ple_w": gain(ks[25], (DEPTH, D_MODEL)),
        "w_ple": nrm(ks[26], (DEPTH, PLE_DIM, D_MODEL), PLE_DIM ** -0.5),
        "w_pg": nrm(ks[27], (DEPTH, D_MODEL, D_MODEL), D_MODEL ** -0.5),
        "final_norm_w": gain(ks[28], (D_MODEL,)),
    }


def reference(x, p, norm_mix_w, w_in, s5_a_re, s5_a_im, s5_log_dt, s5_b_re, s5_b_im, s5_c_re, s5_c_im,
              s5_d, s5_w_glu, s5_b_glu, pool_w, pool_scale, gla_w_a2, gla_b_a, gla_norm_w, w_out,
              norm_ffn_w, w_up, conv_w, conv_b, w_down, norm_ple_w, w_ple, w_pg, final_norm_w):
    h = x
    split_at = list(np.cumsum(IN_SPLITS)[:-1])
    for i in range(DEPTH):
        a = rmsnorm(h, norm_mix_w[i])
        z = a @ w_in[i]
        u_s5, z_pool, q, k, v, g_lr, r = jnp.split(z, split_at, axis=-1)
        y_s5 = s5_mixer(u_s5, s5_a_re[i], s5_a_im[i], s5_log_dt[i], s5_b_re[i], s5_b_im[i],
                        s5_c_re[i], s5_c_im[i], s5_d[i], s5_w_glu[i], s5_b_glu[i])
        y_pool = pool_mixer(z_pool, pool_w[i], pool_scale[i])
        y_gla = gla_mixer(q, k, v, g_lr, r, gla_w_a2[i], gla_b_a[i], gla_norm_w[i])
        mixed = jnp.concatenate([y_s5, y_pool, y_gla], axis=-1)
        h = h + (mixed @ w_out[i]).astype(h.dtype)
        f = conv_glu_ffn(rmsnorm(h, norm_ffn_w[i]), w_up[i], conv_w[i], conv_b[i], w_down[i])
        h = h + f.astype(h.dtype)
        gate = jax.nn.sigmoid(rmsnorm(h, norm_ple_w[i]) @ w_pg[i])
        h = h + ((p[i] @ w_ple[i]) * gate).astype(h.dtype)
    return rmsnorm(h, final_norm_w)
```

```cpp
#include <hip/hip_runtime.h>
#include <hip/hip_cooperative_groups.h>
#include <cstdio>
#include <cstdint>
namespace cg = cooperative_groups;
namespace pg8 {
#define PG8_LAS __attribute__((address_space(3)))
typedef unsigned short bf16_t;
typedef short bf16x8 __attribute__((ext_vector_type(8)));
typedef float f32x4 __attribute__((ext_vector_type(4)));
typedef unsigned u32x4 __attribute__((ext_vector_type(4)));
constexpr int BM = 256, BK = 64, HALF = 128, HTB = HALF * BK * 2  , STAGE_BYTES = 8 * HTB, NXCD = 8, WGM = 8;

__host__ __device__ __forceinline__ int lds_byte(int r, int c) { const int st = (r >> 4) * 2 + (c >> 5), rr = r & 15, cc = c & 31, ob = rr * 64 + cc * 2; return st * 1024 + (ob ^ (((ob >> 9) & 1) << 5)); }
__host__ __device__ __forceinline__ void stage_rc(int b, int& R, int& C) { const int st = b / 1024, sb = b % 1024, swz = sb ^ (((sb >> 9) & 1) << 5); R = (st >> 1) * 16 + swz / 64; C = (st & 1) * 32 + (swz % 64) / 2; }
__host__ __device__ __forceinline__ int perm32(int rho) { const int n = rho >> 4, i = rho & 15; return 8 * (i >> 2) + 4 * n + (i & 3); }

struct Unit { int pm, pn; };
struct Gemm { const bf16_t* A; const bf16_t* Bt; int M, N, K; };

struct StaticOrder {
    int nM, nN, nwg, G, c;
    __host__ __device__ void init(int M, int N, int G_, int c_) { nM = M / BM; nN = N / BM; nwg = nM * nN; G = G_; c = c_; }
    __host__ __device__ bool next(int i, Unit& u) const {
        const long L = (long)i * G + c; if (L >= nwg) return false;
        int wgid = (int)L; { const int q = nwg / NXCD, r = nwg % NXCD, xcd = wgid % NXCD, off = wgid / NXCD; wgid = (xcd < r ? xcd * (q + 1) : r * (q + 1) + (xcd - r) * q) + off; }
        const int nig = WGM * nN, gid = wgid / nig, fm = gid * WGM, gsz = (nM - fm) < WGM ? (nM - fm) : WGM;
        u.pm = fm + ((wgid % nig) % gsz); u.pn = (wgid % nig) / gsz; return true;
    }
    __device__ __forceinline__ void a_ready(const Unit&) const {}
    __device__ __forceinline__ void done(const Unit&) const {}
};
typedef PG8_LAS unsigned char* PG8_LAS_T;

__device__ __forceinline__ unsigned cvt_pk_bf16(float lo, float hi) { unsigned r; asm volatile("v_cvt_pk_bf16_f32 %0, %1, %2" : "=v"(r) : "v"(lo), "v"(hi)); return r; }
typedef unsigned u32x2 __attribute__((ext_vector_type(2)));
constexpr float RMS_EPS = 1e-6f;
constexpr int DM = 2048, DFF = 5632;
__device__ __forceinline__ float sigm(float x) { return 1.0f / (1.0f + __expf(-x)); }
__device__ __forceinline__ float bflo(unsigned u) { return __uint_as_float(u << 16); }
__device__ __forceinline__ float bfhi(unsigned u) { return __uint_as_float(u & 0xffff0000u); }

struct EpiScaleBf16 {
    static constexpr bool PERM = true, AFTER_DRAIN = false;
    bf16_t* O; int ldc; const float* rowsq; float inv_n;
    __device__ __forceinline__ void operator()(const f32x4 (&acc)[2][2][4][2], const Unit& u, int wr, int wc, int fr, int fq) const {
        const int row0 = u.pm * BM + wr * 64 + fr, col0 = u.pn * BM + wc * 32 + 8 * fq;
#pragma unroll
        for (int ai = 0; ai < 2; ++ai)
#pragma unroll
            for (int m = 0; m < 4; ++m) { const int row = row0 + ai * HALF + m * 16; const float rs = rowsq ? rsqrtf(rowsq[row] * inv_n + RMS_EPS) : 1.0f;
                bf16_t* rowp = O + (size_t)row * ldc + col0;
#pragma unroll
                for (int bj = 0; bj < 2; ++bj) { const f32x4 v0 = acc[ai][bj][m][0] * rs, v1 = acc[ai][bj][m][1] * rs;
                    u32x4 w; w.x = cvt_pk_bf16(v0[0], v0[1]); w.y = cvt_pk_bf16(v0[2], v0[3]); w.z = cvt_pk_bf16(v1[0], v1[1]); w.w = cvt_pk_bf16(v1[2], v1[3]);
                    *(u32x4*)(rowp + bj * HALF) = w; } }
    }
};

struct EpiRes {
    static constexpr bool PERM = false, AFTER_DRAIN = false;
    const float* base; float* out; bf16_t* hb; float* sq_next;
    __device__ __forceinline__ void operator()(const f32x4 (&acc)[2][2][4][2], const Unit& u, int wr, int wc, int fr, int fq) const {
        const int row0 = u.pm * BM + wr * 64 + fr, col0 = u.pn * BM + wc * 32 + 4 * fq;
#pragma unroll
        for (int ai = 0; ai < 2; ++ai)
#pragma unroll
            for (int m = 0; m < 4; ++m) { const int row = row0 + ai * HALF + m * 16; const size_t off = (size_t)row * DM + col0; float ss = 0.f;
#pragma unroll
                for (int bj = 0; bj < 2; ++bj)
#pragma unroll
                    for (int n = 0; n < 2; ++n) { const size_t o2 = off + bj * HALF + n * 16; const f32x4 bs = *(const f32x4*)(base + o2); const f32x4 o = bs + acc[ai][bj][m][n];
                        *(f32x4*)(out + o2) = o; u32x2 w; w.x = cvt_pk_bf16(o[0], o[1]); w.y = cvt_pk_bf16(o[2], o[3]); *(u32x2*)(hb + o2) = w;
                        ss += (o[0] * o[0] + o[1] * o[1]) + (o[2] * o[2] + o[3] * o[3]); }
                ss += __shfl_xor(ss, 16); ss += __shfl_xor(ss, 32);
                if (fq == 0) unsafeAtomicAdd(sq_next + row, ss);
                asm volatile("" ::: "memory"); }
    }
};

struct EpiPg {
    static constexpr bool PERM = false, AFTER_DRAIN = false;
    const float* base; float* out; bf16_t* hb; float* sq_next; const float* rowsq; const bf16_t* ple;
    __device__ __forceinline__ void operator()(const f32x4 (&acc)[2][2][4][2], const Unit& u, int wr, int wc, int fr, int fq) const {
        const int row0 = u.pm * BM + wr * 64 + fr, col0 = u.pn * BM + wc * 32 + 4 * fq;
#pragma unroll
        for (int ai = 0; ai < 2; ++ai)
#pragma unroll
            for (int m = 0; m < 4; ++m) { const int row = row0 + ai * HALF + m * 16; const size_t off = (size_t)row * DM + col0; float ss = 0.f;
                const float rs = rsqrtf(rowsq[row] * (1.0f / DM) + RMS_EPS);
#pragma unroll
                for (int bj = 0; bj < 2; ++bj)
#pragma unroll
                    for (int n = 0; n < 2; ++n) { const size_t o2 = off + bj * HALF + n * 16; const f32x4 bs = *(const f32x4*)(base + o2); const u32x2 pl = *(const u32x2*)(ple + o2);
                        const f32x4 a = acc[ai][bj][m][n] * rs; f32x4 o;
                        o[0] = bs[0] + bflo(pl.x) * sigm(a[0]); o[1] = bs[1] + bfhi(pl.x) * sigm(a[1]); o[2] = bs[2] + bflo(pl.y) * sigm(a[2]); o[3] = bs[3] + bfhi(pl.y) * sigm(a[3]);
                        *(f32x4*)(out + o2) = o; u32x2 w; w.x = cvt_pk_bf16(o[0], o[1]); w.y = cvt_pk_bf16(o[2], o[3]); *(u32x2*)(hb + o2) = w;
                        ss += (o[0] * o[0] + o[1] * o[1]) + (o[2] * o[2] + o[3] * o[3]); }
                ss += __shfl_xor(ss, 16); ss += __shfl_xor(ss, 32);
                if (fq == 0) unsafeAtomicAdd(sq_next + row, ss);
                asm volatile("" ::: "memory"); }
    }
};

struct EpiGlu {
    static constexpr bool PERM = true, AFTER_DRAIN = false;
    const bf16_t* ybuf; const float* bias; bf16_t* O;
    __device__ __forceinline__ void operator()(const f32x4 (&acc)[2][2][4][2], const Unit& u, int wr, int wc, int fr, int fq) const {
        const int row0 = u.pm * BM + wr * 64 + fr, col0 = u.pn * BM + wc * 32 + 8 * fq;
#pragma unroll
        for (int ai = 0; ai < 2; ++ai)
#pragma unroll
            for (int m = 0; m < 4; ++m) { const int row = row0 + ai * HALF + m * 16;
#pragma unroll
                for (int bj = 0; bj < 2; ++bj) { const int c = col0 + bj * HALF; const u32x4 yv = *(const u32x4*)(ybuf + (size_t)row * 512 + c);
                    const f32x4 b0 = *(const f32x4*)(bias + c), b1 = *(const f32x4*)(bias + c + 4); const f32x4 a0 = acc[ai][bj][m][0] + b0, a1 = acc[ai][bj][m][1] + b1;
                    u32x4 w; w.x = cvt_pk_bf16(bflo(yv.x) * sigm(a0[0]), bfhi(yv.x) * sigm(a0[1])); w.y = cvt_pk_bf16(bflo(yv.y) * sigm(a0[2]), bfhi(yv.y) * sigm(a0[3]));
                    w.z = cvt_pk_bf16(bflo(yv.z) * sigm(a1[0]), bfhi(yv.z) * sigm(a1[1])); w.w = cvt_pk_bf16(bflo(yv.w) * sigm(a1[2]), bfhi(yv.w) * sigm(a1[3]));
                    *(u32x4*)(O + (size_t)row * DM + c) = w; } }
    }
};

struct EpiUp {
    static constexpr bool PERM = true, AFTER_DRAIN = false;
    bf16_t* act; const float* rowsq; const float* cw; const float* cb; float* headg; float* headv; float* tailg;
    __device__ __forceinline__ void operator()(const f32x4 (&acc)[2][2][4][2], const Unit& u, int wr, int wc, int fr, int fq) const {
        const int row0 = u.pm * BM + wr * 64 + fr, f00 = u.pn * HALF + wc * 32 + 8 * fq;
        const int lane = (int)(threadIdx.x & 63); const int src1 = (lane & 48) | ((fr + 15) & 15), src2 = (lane & 48) | ((fr + 14) & 15);
#pragma unroll
        for (int ai = 0; ai < 2; ++ai) {
            float rs[4];
#pragma unroll
            for (int m = 0; m < 4; ++m) rs[m] = rsqrtf(rowsq[row0 + ai * HALF + m * 16] * (1.0f / DM) + RMS_EPS);
            const int G = u.pm * 4 + ai * 2 + wr;
#pragma unroll
            for (int n = 0; n < 2; ++n) { const int f0 = f00 + 4 * n;
                const f32x4 w0 = *(const f32x4*)(cw + f0), w1 = *(const f32x4*)(cw + DFF + f0), w2 = *(const f32x4*)(cw + 2 * DFF + f0), bb = *(const f32x4*)(cb + f0);
                f32x4 r1p = (f32x4){0.f, 0.f, 0.f, 0.f}, r2p = r1p;
#pragma unroll
                for (int m = 0; m < 4; ++m) { const int row = row0 + ai * HALF + m * 16;
                    const f32x4 g = acc[ai][0][m][n] * rs[m], v = acc[ai][1][m][n] * rs[m]; f32x4 r1, r2;
#pragma unroll
                    for (int j = 0; j < 4; ++j) { r1[j] = __shfl(g[j], src1); r2[j] = __shfl(g[j], src2); }
                    f32x4 p1, p2;
#pragma unroll
                    for (int j = 0; j < 4; ++j) { p1[j] = fr >= 1 ? r1[j] : r1p[j]; p2[j] = fr >= 2 ? r2[j] : r2p[j]; }
                    if (m == 0 && fr < 2) { *(f32x4*)(headg + ((size_t)G * 2 + fr) * DFF + f0) = g; *(f32x4*)(headv + ((size_t)G * 2 + fr) * DFF + f0) = v; }
                    else { f32x4 gc = bb + w0 * p2 + w1 * p1 + w2 * g; f32x4 a;
#pragma unroll
                        for (int j = 0; j < 4; ++j) a[j] = gc[j] * sigm(gc[j]) * v[j];
                        u32x2 w; w.x = cvt_pk_bf16(a[0], a[1]); w.y = cvt_pk_bf16(a[2], a[3]); *(u32x2*)(act + (size_t)row * DFF + f0) = w; }
                    if (m == 3 && fr >= 14) *(f32x4*)(tailg + ((size_t)G * 2 + (fr - 14)) * DFF + f0) = g;
                    r1p = r1; r2p = r2; }
            }
        }
    }
};

template <class Epi, class Sched, bool ALIGN_EPI = false, bool SP2 = false>
__device__ __forceinline__ void gemm_phase(PG8_LAS unsigned char* lds, const Gemm g, const Sched& S, const Epi& E) {
    int tid_l = threadIdx.x; asm volatile("" : "+v"(tid_l)); const int tid = tid_l, wid = __builtin_amdgcn_readfirstlane(tid >> 6), lane = tid & 63, wr = wid >> 2, wc = wid & 3, fr = lane & 15, fq = lane >> 4;
    const int K = g.K, nt = K / BK;
    unsigned voffA[2], voffB[2];
#pragma unroll
    for (int i = 0; i < 2; ++i) { int R, C; stage_rc(tid * 16 + i * 8192, R, C); const int Rb = Epi::PERM ? ((R & ~31) + perm32(R & 31)) : R;
        voffA[i] = (unsigned)(R * K + C) * 2u; voffB[i] = (unsigned)(Rb * K + C) * 2u; }
    const size_t kstep = (size_t)(BK * 2);
    const size_t hstep = (size_t)HALF * K * 2;
    const size_t tstep = 2 * hstep;
    const unsigned ldsw = (unsigned)wid * 1024u;
    const int aoff = lds_byte(wr * 64 + fr, fq * 8), boff = lds_byte(wc * 32 + fr, fq * 8);
#define PG8_SA(b, h) (((b) * 2 + (h)) * HTB)
#define PG8_SB(b, h) ((4 + (b) * 2 + (h)) * HTB)
#define PG8_STAGE(bufoff, gbase, voff) do { _Pragma("unroll") for (int _i = 0; _i < 2; ++_i) \
        __builtin_amdgcn_global_load_lds((const unsigned*)((const char*)(gbase) + (voff)[_i]), (PG8_LAS unsigned*)(lds + (bufoff) + ldsw + _i * 8192), 16, 0, 0); } while (0)
#define PG8_LDA(dst, b, h) do { _Pragma("unroll") for (int m = 0; m < 4; ++m) _Pragma("unroll") for (int k = 0; k < 2; ++k) dst[m][k] = *(const PG8_LAS bf16x8*)(lds + PG8_SA(b, h) + aoff + m * 2048 + k * 1024); } while (0)
#define PG8_LDB(dst, b, h) do { _Pragma("unroll") for (int n = 0; n < 2; ++n) _Pragma("unroll") for (int k = 0; k < 2; ++k) dst[n][k] = *(const PG8_LAS bf16x8*)(lds + PG8_SB(b, h) + boff + n * 2048 + k * 1024); } while (0)
#define PG8_MMA(ai, bj, At, Bt) do { __builtin_amdgcn_s_setprio(1); _Pragma("unroll") for (int m = 0; m < 4; ++m) _Pragma("unroll") for (int n = 0; n < 2; ++n) _Pragma("unroll") for (int k = 0; k < 2; ++k) \
        acc[ai][bj][m][n] = __builtin_amdgcn_mfma_f32_16x16x32_bf16(Bt[n][k], At[m][k], acc[ai][bj][m][n], 0, 0, 0); __builtin_amdgcn_s_setprio(0); } while (0)
#define PG8_WAIT_V(n) asm volatile("s_waitcnt vmcnt(" #n ")" ::: "memory")
#define PG8_WAIT_L(n) asm volatile("s_waitcnt lgkmcnt(" #n ")" ::: "memory")
#define PG8_BAR __builtin_amdgcn_s_barrier()
#define PG8_SCHED __builtin_amdgcn_sched_barrier(0)
    Unit cur, nxt; int ui = 0;
    if (!S.next(0, cur)) return;
    f32x4 acc[2][2][4][2];
#pragma unroll
    for (int a = 0; a < 2; ++a)
#pragma unroll
        for (int b = 0; b < 2; ++b)
#pragma unroll
            for (int m = 0; m < 4; ++m)
#pragma unroll
                for (int n = 0; n < 2; ++n) acc[a][b][m][n] = (f32x4){0.f, 0.f, 0.f, 0.f};
    bf16x8 At[4][2], B0[2][2], B1[2][2];
    const char* cA = (const char*)g.A + (size_t)cur.pm * tstep; const char* cB = (const char*)g.Bt + (size_t)cur.pn * tstep;
    S.a_ready(cur);
    if constexpr (SP2) {
        PG8_STAGE(PG8_SB(0, 0), cB, voffB); PG8_STAGE(PG8_SB(0, 1), cB + hstep, voffB); PG8_STAGE(PG8_SA(0, 0), cA, voffA); PG8_STAGE(PG8_SA(0, 1), cA + hstep, voffA);
        if (wr == 1) PG8_BAR;
        PG8_WAIT_V(2); PG8_BAR;
        PG8_STAGE(PG8_SB(1, 0), cB + kstep, voffB); PG8_STAGE(PG8_SA(1, 0), cA + kstep, voffA); PG8_STAGE(PG8_SB(1, 1), cB + hstep + kstep, voffB);
        PG8_WAIT_V(6); PG8_BAR;
    } else {
        PG8_STAGE(PG8_SB(0, 0), cB, voffB); PG8_STAGE(PG8_SA(0, 0), cA, voffA); PG8_STAGE(PG8_SB(0, 1), cB + hstep, voffB); PG8_STAGE(PG8_SA(0, 1), cA + hstep, voffA);
        if (wr == 1) PG8_BAR;
        PG8_WAIT_V(4); PG8_BAR;
        PG8_STAGE(PG8_SB(1, 0), cB + kstep, voffB); PG8_STAGE(PG8_SA(1, 0), cA + kstep, voffA); PG8_STAGE(PG8_SB(1, 1), cB + hstep + kstep, voffB);
        PG8_WAIT_V(6); PG8_BAR;
    }
    for (;;) {
        const bool has_next = S.next(ui + 1, nxt);
        const char* nA = has_next ? (const char*)g.A + (size_t)nxt.pm * tstep : cA; const char* nB = has_next ? (const char*)g.Bt + (size_t)nxt.pn * tstep : cB;
        for (int t = 0; t < nt; t += 2) {
            const bool last = (t == nt - 2);
            const char* a1 = cA + (size_t)(t + 1) * kstep;
            const char* a2 = last ? nA : cA + (size_t)(t + 2) * kstep; const char* b2 = last ? nB : cB + (size_t)(t + 2) * kstep;
            const char* a3 = a2 + kstep; const char* b3 = b2 + kstep;
            if (last && has_next) S.a_ready(nxt);
            if constexpr (SP2) {
            PG8_LDB(B0, 0, 0); PG8_LDB(B1, 0, 1); PG8_SCHED; PG8_LDA(At, 0, 0); PG8_STAGE(PG8_SA(1, 1), a1 + hstep, voffA);
            PG8_WAIT_V(8); PG8_WAIT_L(0); PG8_BAR; PG8_MMA(0, 0, At, B0); PG8_MMA(0, 1, At, B1); PG8_BAR; PG8_SCHED;
            PG8_LDA(At, 0, 1); PG8_STAGE(PG8_SB(0, 0), b2, voffB); PG8_STAGE(PG8_SB(0, 1), b2 + hstep, voffB); PG8_STAGE(PG8_SA(0, 0), a2, voffA);
            PG8_WAIT_V(8); PG8_WAIT_L(0); PG8_BAR; PG8_MMA(1, 0, At, B0); PG8_MMA(1, 1, At, B1); PG8_BAR; PG8_SCHED;
            PG8_LDB(B0, 1, 0); PG8_LDB(B1, 1, 1); PG8_SCHED; PG8_LDA(At, 1, 0); PG8_STAGE(PG8_SA(0, 1), a2 + hstep, voffA);
            PG8_WAIT_V(8); PG8_WAIT_L(0); PG8_BAR; PG8_MMA(0, 0, At, B0); PG8_MMA(0, 1, At, B1); PG8_BAR; PG8_SCHED;
            PG8_LDA(At, 1, 1); PG8_STAGE(PG8_SB(1, 0), b3, voffB); PG8_STAGE(PG8_SB(1, 1), b3 + hstep, voffB); PG8_STAGE(PG8_SA(1, 0), a3, voffA);
            PG8_WAIT_V(8); PG8_WAIT_L(0); PG8_BAR; PG8_MMA(1, 0, At, B0); PG8_MMA(1, 1, At, B1); PG8_BAR; PG8_SCHED;
            } else {
            PG8_LDB(B0, 0, 0); PG8_SCHED; PG8_LDA(At, 0, 0); PG8_STAGE(PG8_SA(1, 1), a1 + hstep, voffA);
            PG8_WAIT_L(8); PG8_BAR; PG8_WAIT_L(0); PG8_MMA(0, 0, At, B0); PG8_BAR; PG8_SCHED;
            PG8_LDB(B1, 0, 1); PG8_STAGE(PG8_SB(0, 0), b2, voffB);
            PG8_BAR; PG8_WAIT_L(0); PG8_MMA(0, 1, At, B1); PG8_BAR;
            PG8_LDA(At, 0, 1); PG8_STAGE(PG8_SA(0, 0), a2, voffA);
            PG8_BAR; PG8_WAIT_L(0); PG8_MMA(1, 0, At, B0); PG8_BAR; PG8_SCHED;
            PG8_STAGE(PG8_SB(0, 1), b2 + hstep, voffB);
            PG8_WAIT_V(6); PG8_BAR; PG8_MMA(1, 1, At, B1); PG8_BAR;
            PG8_LDB(B0, 1, 0); PG8_SCHED; PG8_LDA(At, 1, 0); PG8_STAGE(PG8_SA(0, 1), a2 + hstep, voffA);
            PG8_WAIT_L(8); PG8_BAR; PG8_WAIT_L(0); PG8_MMA(0, 0, At, B0); PG8_BAR; PG8_SCHED;
            PG8_LDB(B1, 1, 1); PG8_STAGE(PG8_SB(1, 0), b3, voffB);
            PG8_BAR; PG8_WAIT_L(0); PG8_MMA(0, 1, At, B1); PG8_BAR;
            PG8_LDA(At, 1, 1); PG8_STAGE(PG8_SA(1, 0), a3, voffA);
            PG8_BAR; PG8_WAIT_L(0); PG8_MMA(1, 0, At, B0); PG8_BAR; PG8_SCHED;
            PG8_STAGE(PG8_SB(1, 1), b3 + hstep, voffB);
            PG8_WAIT_V(6); PG8_BAR; PG8_MMA(1, 1, At, B1); PG8_BAR;
            }
        }
        if constexpr (ALIGN_EPI) { if (wr == 0) PG8_BAR; }
        if constexpr (!Epi::AFTER_DRAIN) { E(acc, cur, wr, wc, fr, fq); S.done(cur); }
        if (!has_next) break;
#pragma unroll
        for (int a = 0; a < 2; ++a)
#pragma unroll
            for (int b = 0; b < 2; ++b)
#pragma unroll
                for (int m = 0; m < 4; ++m)
#pragma unroll
                    for (int n = 0; n < 2; ++n) acc[a][b][m][n] = (f32x4){0.f, 0.f, 0.f, 0.f};
        cur = nxt; cA = nA; cB = nB; ++ui;
        if constexpr (ALIGN_EPI) { if (wr == 1) PG8_BAR; }
    }
    PG8_WAIT_V(0);
    if constexpr (!ALIGN_EPI) { if (wr == 0) PG8_BAR; }
    PG8_BAR;
    if constexpr (Epi::AFTER_DRAIN) { E.fused(acc, cur, wr, wc, fr, fq, lds, wid, lane); S.done(cur); }
#undef PG8_SA
#undef PG8_SB
#undef PG8_STAGE
#undef PG8_LDA
#undef PG8_LDB
#undef PG8_MMA
#undef PG8_WAIT_V
#undef PG8_WAIT_L
#undef PG8_BAR
#undef PG8_SCHED
}
}

typedef unsigned short bf16;
typedef short bf16x8 __attribute__((ext_vector_type(8)));
typedef float f32x4 __attribute__((ext_vector_type(4)));
typedef unsigned u32x4 __attribute__((ext_vector_type(4)));
typedef unsigned u32x2 __attribute__((ext_vector_type(2)));
constexpr int M = 16384, D = 2048, NIN = 4112, LDZ = 4352, DFF = 5632, NUP = 11264, PLED = 256;
constexpr int Z_POOL = 512, Z_Q = 1024, Z_K = 1536, Z_V = 2048, Z_G = 3072, Z_R = 3088;
constexpr int NCH = 256;
constexpr int S5T = 16, S5NC = 1024;
constexpr float EPS = 1e-6f;
constexpr size_t MiB = 1u << 20;
constexpr size_t WS_SQ = 0;
constexpr size_t WS_L0 = 1 * MiB, WS_LSTRIDE = 110 * MiB;
constexpr size_t L_WIN = 0, L_WOUT = 17 * MiB, L_WUP = 25 * MiB, L_WDN = 69 * MiB, L_WPG = 91 * MiB, L_WPLE = 99 * MiB, L_WGLU = 100 * MiB, L_POOLW = 100 * MiB + 512 * 1024,
                 L_PT = 101 * MiB, L_QT = 103 * MiB, L_BT = 105 * MiB, L_A16 = 109 * MiB;
constexpr size_t WS_HB = 221 * MiB, WS_PB = 285 * MiB, WS_MIX = 301 * MiB, WS_R1 = 365 * MiB;
constexpr size_t WS_Z = WS_R1, WS_ST = WS_R1 + 136 * MiB, WS_E = WS_ST + 128 * MiB, WS_SB = WS_E + 16 * MiB, WS_Y = WS_SB + 8 * MiB, WS_DEC = WS_Y + 16 * MiB;
constexpr size_t WS_ACT = WS_R1, WS_HEADG = WS_R1 + 176 * MiB, WS_HEADV = WS_HEADG + 11 * MiB, WS_TAILG = WS_HEADV + 11 * MiB;
constexpr size_t WS_HB2 = WS_R1 + 209 * MiB;
constexpr size_t WS_END = WS_DEC + 1 * MiB;
constexpr int LDS_BYTES = 147456;
constexpr int NPHASE = 22;
#ifndef PHASE_MASK
#define PHASE_MASK 0xFFF
#endif
#define EN(x) ((PHASE_MASK >> (x)) & 1)
#ifndef SUB
#define SUB 7
#endif

__device__ __forceinline__ unsigned f2bf(float f) { unsigned u = __float_as_uint(f); return (u + 0x7fffu + ((u >> 16) & 1u)) >> 16; }
__device__ __forceinline__ unsigned pk2(float lo, float hi) { return f2bf(lo) | (f2bf(hi) << 16); }
__device__ __forceinline__ float bf2f(bf16 b) { return __uint_as_float(((unsigned)b) << 16); }
__device__ __forceinline__ float blo(unsigned u) { return __uint_as_float(u << 16); }
__device__ __forceinline__ float bhi(unsigned u) { return __uint_as_float(u & 0xffff0000u); }
__device__ __forceinline__ bf16x8 ld8(const bf16* p) { return *(const bf16x8*)p; }
__device__ __forceinline__ f32x4 mma(bf16x8 b, bf16x8 a, f32x4 c) { return __builtin_amdgcn_mfma_f32_16x16x32_bf16(b, a, c, 0, 0, 0); }
__device__ __forceinline__ float wave_sum(float v) {
#pragma unroll
    for (int o = 1; o < 64; o <<= 1) v += __shfl_xor(v, o);
    return v;
}
__device__ __forceinline__ float gelu_tanh(float x) { const float y = 0.7978845608f * (x + 0.044715f * x * x * x); const float e = __expf(2.0f * y); return 0.5f * x * (2.0f - 2.0f / (e + 1.0f)); }

__device__ __forceinline__ int tid_opaque() { int t = threadIdx.x; asm volatile("" : "+v"(t)); return t; }
struct Args { const float* in[29]; float* out; unsigned char* ws; int ph_lo, ph_hi; };
typedef const __attribute__((address_space(4))) Args* KArgs;

__device__ __forceinline__ void transpose_item(const float* W, int ldw, int nvalid, const float* kscale, bf16* WT, int ldt, int drow0, int k0, int n0, float* scr, int lane) {
    const int nn = n0 + (lane & 31); const bool ok = nn < nvalid;
#pragma unroll 8
    for (int i = 0; i < 32; ++i) { const int kk = 2 * i + (lane >> 5); float v = ok ? W[(size_t)(k0 + kk) * ldw + nn] : 0.f; if (kscale) v *= kscale[k0 + kk]; scr[kk * 33 + (lane & 31)] = v; }
    asm volatile("s_waitcnt lgkmcnt(0)" ::: "memory");
    const int c = lane & 7;
#pragma unroll
    for (int j = 0; j < 4; ++j) { const int n = (lane >> 3) + 8 * j; const float* s = scr + (8 * c) * 33 + n;
        u32x4 o; o.x = pk2(s[0 * 33], s[1 * 33]); o.y = pk2(s[2 * 33], s[3 * 33]); o.z = pk2(s[4 * 33], s[5 * 33]); o.w = pk2(s[6 * 33], s[7 * 33]);
        *(u32x4*)(WT + (size_t)(drow0 + n) * ldt + k0 + 8 * c) = o; }
    asm volatile("s_waitcnt lgkmcnt(0)" ::: "memory");
}

__device__ __forceinline__ void s5_precompute(KArgs A, int l, int g, unsigned char* wl, float* L) {
    const int tid = tid_opaque(); const int lg = l * 32 + g;
    float* powr = L; float* powi = L + 1088; float* Bbr = L + 2176; float* Bbi = L + 3200; float* Cr = L + 4224; float* Ci = L + 5248; float* Km = L + 6272;
    const float* a_re = A->in[4] + lg * 64; const float* a_im = A->in[5] + lg * 64;
    const double dt = (double)expf(A->in[6][lg]);
    for (int idx = tid; idx < 17 * 64; idx += 512) { const int d = idx >> 6, n = idx & 63;
        const double ang = (double)a_im[n] * dt * d, mag = exp((double)a_re[n] * dt * d); powr[idx] = (float)(mag * cos(ang)); powi[idx] = (float)(mag * sin(ang)); }
    for (int idx = tid; idx < 1024; idx += 512) { const int n = idx >> 4, c = idx & 15;
        const double are = a_re[n], aim = a_im[n], zr = are * dt, zi = aim * dt, e = exp(zr), er = e * cos(zi) - 1.0, ei = e * sin(zi), den = are * are + aim * aim;
        const double fr = (er * are + ei * aim) / den, fi = (ei * are - er * aim) / den;
        const double br = A->in[7][(size_t)(lg * 64 + n) * 16 + c], bi = A->in[8][(size_t)(lg * 64 + n) * 16 + c];
        Bbr[idx] = (float)(fr * br - fi * bi); Bbi[idx] = (float)(fr * bi + fi * br); }
    for (int idx = tid; idx < 1024; idx += 512) { Cr[idx] = A->in[9][(size_t)lg * 1024 + idx]; Ci[idx] = A->in[10][(size_t)lg * 1024 + idx]; }
    __syncthreads();
    for (int idx = tid; idx < 4096; idx += 512) { const int d = idx >> 8, cp = (idx >> 4) & 15, c = idx & 15; float s = 0.f;
        for (int n = 0; n < 64; ++n) { const float cr = Cr[cp * 64 + n], ci = Ci[cp * 64 + n], pr = powr[d * 64 + n], pi = powi[d * 64 + n];
            const float wr = cr * pr - ci * pi, wi = cr * pi + ci * pr; s += wr * Bbr[n * 16 + c] - wi * Bbi[n * 16 + c]; }
        Km[idx] = s; }
    __syncthreads();
    bf16* Pt = (bf16*)(wl + L_PT) + (size_t)g * 128 * 256; bf16* QT = (bf16*)(wl + L_QT) + (size_t)g * 256 * 128; bf16* BT = (bf16*)(wl + L_BT) + (size_t)g * 256 * 256; float* A16 = (float*)(wl + L_A16) + g * 128;
    for (int idx = tid; idx < 32768; idx += 512) { const int np = idx >> 8, j = idx & 255, s = j >> 4, c = j & 15, n = np & 63;
        const float pr = powr[(15 - s) * 64 + n], pi = powi[(15 - s) * 64 + n], br = Bbr[n * 16 + c], bi = Bbi[n * 16 + c];
        Pt[idx] = (bf16)f2bf(np < 64 ? (pr * br - pi * bi) : (pr * bi + pi * br)); }
    for (int idx = tid; idx < 32768; idx += 512) { const int nn = idx >> 7, np = idx & 127, t = nn >> 4, cp = nn & 15, n = np & 63;
        const float pr = powr[(t + 1) * 64 + n], pi = powi[(t + 1) * 64 + n], cr = Cr[cp * 64 + n], ci = Ci[cp * 64 + n];
        QT[idx] = (bf16)f2bf(np < 64 ? (cr * pr - ci * pi) : -(cr * pi + ci * pr)); }
    for (int idx = tid; idx < 65536; idx += 512) { const int nn = idx >> 8, j = idx & 255, t = nn >> 4, cp = nn & 15, s = j >> 4, c = j & 15;
        BT[idx] = (bf16)f2bf(s <= t ? Km[(t - s) * 256 + cp * 16 + c] : 0.f); }
    if (tid < 64) { A16[tid * 2] = powr[16 * 64 + tid]; A16[tid * 2 + 1] = powi[16 * 64 + tid]; }
    __syncthreads();
}

__device__ __forceinline__ void phase_prologue(KArgs A, unsigned char* lds) {
    const int tid = tid_opaque(), lane = tid & 63, wave = __builtin_amdgcn_readfirstlane(tid >> 6);
    const int G = gridDim.x, gw = blockIdx.x * 8 + wave, NGW = G * 8, gt = blockIdx.x * 512 + tid, NGT = G * 512;
    unsigned char* ws = A->ws;
    for (int it = blockIdx.x; it < 64; it += G) s5_precompute(A, it >> 5, it & 31, ws + WS_L0 + (size_t)(it >> 5) * WS_LSTRIDE, (float*)lds);
    { float* sq = (float*)(ws + WS_SQ); for (int i = gt; i < 6 * M; i += NGT) sq[M + i] = 0.f; }
    { const f32x4* p4 = (const f32x4*)A->in[1]; u32x2* o = (u32x2*)(ws + WS_PB); for (int i = gt; i < 2 * M * PLED / 4; i += NGT) { const f32x4 v = p4[i]; u32x2 w; w.x = pk2(v[0], v[1]); w.y = pk2(v[2], v[3]); o[i] = w; } }
    { float* sq = (float*)(ws + WS_SQ); bf16* hb = (bf16*)(ws + WS_HB);
      for (int m = gw; m < M; m += NGW) { const f32x4* xr = (const f32x4*)(A->in[0] + (size_t)m * D) + lane; u32x2* o = (u32x2*)(hb + (size_t)m * D) + lane; float s = 0.f;
#pragma unroll
          for (int j = 0; j < 8; ++j) { const f32x4 v = xr[64 * j]; s += (v[0] * v[0] + v[1] * v[1]) + (v[2] * v[2] + v[3] * v[3]); u32x2 w; w.x = pk2(v[0], v[1]); w.y = pk2(v[2], v[3]); o[64 * j] = w; }
          s = wave_sum(s); if (lane == 0) sq[m] = s; } }
    float* scr = (float*)(lds + wave * 16384);
    constexpr int I_IN = 32 * 136, I_OUT = 32 * 64, I_UP = 32 * 352, I_DN = 88 * 64, I_PG = 32 * 64, I_PLE = 4 * 64, I_GLU = 8 * 16, I_POOL = 32;
    constexpr int I_LAYER = I_IN + I_OUT + I_UP + I_DN + I_PG + I_PLE + I_GLU + I_POOL;
    for (int it = gw; it < 2 * I_LAYER; it += NGW) {
        const int l = it >= I_LAYER ? 1 : 0; int r = it - l * I_LAYER; unsigned char* wl = ws + WS_L0 + (size_t)l * WS_LSTRIDE;
        if (r < I_IN) { const int kb = r / 136, nb = r % 136; transpose_item(A->in[3] + (size_t)l * D * NIN, NIN, NIN, A->in[2] + l * D, (bf16*)(wl + L_WIN), D, 32 * nb, 64 * kb, 32 * nb, scr, lane); continue; } r -= I_IN;
        if (r < I_OUT) { const int kb = r / 64, nb = r % 64; transpose_item(A->in[19] + (size_t)l * D * D, D, D, nullptr, (bf16*)(wl + L_WOUT), D, 32 * nb, 64 * kb, 32 * nb, scr, lane); continue; } r -= I_OUT;
        if (r < I_UP) { const int kb = r / 352, nb = r % 352, n0 = 32 * nb, isv = n0 >= DFF ? 1 : 0, f = n0 - isv * DFF, drow = (f >> 7) * 256 + isv * 128 + (f & 127);
            transpose_item(A->in[21] + (size_t)l * D * NUP, NUP, NUP, A->in[20] + l * D, (bf16*)(wl + L_WUP), D, drow, 64 * kb, n0, scr, lane); continue; } r -= I_UP;
        if (r < I_DN) { const int kb = r / 64, nb = r % 64; transpose_item(A->in[24] + (size_t)l * DFF * D, D, D, nullptr, (bf16*)(wl + L_WDN), DFF, 32 * nb, 64 * kb, 32 * nb, scr, lane); continue; } r -= I_DN;
        if (r < I_PG) { const int kb = r / 64, nb = r % 64; transpose_item(A->in[27] + (size_t)l * D * D, D, D, A->in[25] + l * D, (bf16*)(wl + L_WPG), D, 32 * nb, 64 * kb, 32 * nb, scr, lane); continue; } r -= I_PG;
        if (r < I_PLE) { const int kb = r / 64, nb = r % 64; transpose_item(A->in[26] + (size_t)l * PLED * D, D, D, nullptr, (bf16*)(wl + L_WPLE), PLED, 32 * nb, 64 * kb, 32 * nb, scr, lane); continue; } r -= I_PLE;
        if (r < I_GLU) { const int kb = r / 16, nb = r % 16; transpose_item(A->in[12] + (size_t)l * 512 * 512, 512, 512, nullptr, (bf16*)(wl + L_WGLU), 512, 32 * nb, 64 * kb, 32 * nb, scr, lane); continue; } r -= I_GLU;
        { const int gi = r >> 3, kb = (r >> 2) & 1, nb = r & 3; transpose_item(A->in[14] + (size_t)(l * 4 + gi) * 128 * 128, 128, 128, nullptr, (bf16*)(wl + L_POOLW) + gi * 128 * 128, 128, 32 * nb, 64 * kb, 32 * nb, scr, lane); }
    }
}

__device__ __forceinline__ void s5_phase_a(const unsigned char* wl, const bf16* z, float* E, int gw, int NGW, int lane) {
    const int r = lane & 15, q = lane >> 4; const bf16* Pt = (const bf16*)(wl + L_PT);
    for (int task = gw; task < 2048; task += NGW) { const int g = task & 31, mb = task >> 5, k = mb * 16 + r;
        f32x4 acc[8];
#pragma unroll
        for (int i = 0; i < 8; ++i) acc[i] = (f32x4){0.f, 0.f, 0.f, 0.f};
        const bf16* arow = z + (size_t)(k * 16) * LDZ + g * 16 + (size_t)(q >> 1) * LDZ + (q & 1) * 8;
        const bf16* brow = Pt + (size_t)(g * 128 + r) * 256 + q * 8;
#pragma unroll 1
        for (int kk = 0; kk < 8; ++kk) { const bf16x8 a = ld8(arow + (size_t)(2 * kk) * LDZ); const bf16* bp = brow + kk * 32;
#pragma unroll
            for (int nt = 0; nt < 8; ++nt) acc[nt] = mma(ld8(bp + (size_t)nt * 16 * 256), a, acc[nt]); }
#pragma unroll
        for (int nt = 0; nt < 8; ++nt) *(f32x4*)(E + ((size_t)k * 32 + g) * 128 + nt * 16 + 4 * q) = acc[nt];
    }
}
__device__ __forceinline__ void s5_phase_c(const unsigned char* wl, const bf16* z, const bf16* Sb, const float* dskip, bf16* ybuf, int gw, int NGW, int lane) {
    const int r = lane & 15, q = lane >> 4; const bf16* QT = (const bf16*)(wl + L_QT); const bf16* BT = (const bf16*)(wl + L_BT);
    for (int task = gw; task < 2048; task += NGW) { const int g = task & 31, mb = task >> 5, k = mb * 16 + r;
        f32x4 acc[16];
#pragma unroll
        for (int i = 0; i < 16; ++i) acc[i] = (f32x4){0.f, 0.f, 0.f, 0.f};
        const bf16* srow = Sb + ((size_t)k * 32 + g) * 128 + q * 8; const bf16* qrow = QT + (size_t)(g * 256 + r) * 128 + q * 8;
#pragma unroll 1
        for (int kk = 0; kk < 4; ++kk) { const bf16x8 a = ld8(srow + kk * 32); const bf16* bp = qrow + kk * 32;
#pragma unroll
            for (int nt = 0; nt < 16; ++nt) acc[nt] = mma(ld8(bp + (size_t)nt * 16 * 128), a, acc[nt]); }
        const bf16* arow = z + (size_t)(k * 16) * LDZ + g * 16 + (size_t)(q >> 1) * LDZ + (q & 1) * 8; const bf16* brow = BT + (size_t)(g * 256 + r) * 256 + q * 8;
#pragma unroll 1
        for (int kk = 0; kk < 8; ++kk) { const bf16x8 a = ld8(arow + (size_t)(2 * kk) * LDZ); const bf16* bp = brow + kk * 32;
#pragma unroll
            for (int nt = 0; nt < 16; ++nt) if (2 * kk <= nt) acc[nt] = mma(ld8(bp + (size_t)nt * 16 * 256), a, acc[nt]); }
        const f32x4 dsk = *(const f32x4*)(dskip + g * 16 + 4 * q);
#pragma unroll
        for (int nt = 0; nt < 16; ++nt) { const size_t tok = (size_t)k * 16 + nt; const u32x2 uv = *(const u32x2*)(z + tok * LDZ + g * 16 + 4 * q);
            const float y0 = gelu_tanh(acc[nt][0] + dsk[0] * blo(uv.x)), y1 = gelu_tanh(acc[nt][1] + dsk[1] * bhi(uv.x)), y2 = gelu_tanh(acc[nt][2] + dsk[2] * blo(uv.y)), y3 = gelu_tanh(acc[nt][3] + dsk[3] * bhi(uv.y));
            u32x2 w; w.x = pk2(y0, y1); w.y = pk2(y2, y3); *(u32x2*)(ybuf + tok * 512 + g * 16 + 4 * q) = w; }
    }
}
__device__ __forceinline__ void pool_phase(const unsigned char* wl, const bf16* z, const float* pscale, bf16* mixed, int gw, int NGW, int lane) {
    const int r = lane & 15, q = lane >> 4; const bf16* PW = (const bf16*)(wl + L_POOLW);
    for (int task = gw; task < 4096; task += NGW) { const int gi = task & 3, tb = task >> 2, t = tb * 16 + r, w = 2 << gi; const int cnt = (t + 1) < w ? (t + 1) : w; const float inv = 1.0f / (float)cnt;
        f32x4 acc[8];
#pragma unroll
        for (int i = 0; i < 8; ++i) acc[i] = (f32x4){0.f, 0.f, 0.f, 0.f};
#pragma unroll 1
        for (int kk = 0; kk < 4; ++kk) { const bf16* zp = z + (size_t)t * LDZ + Z_POOL + gi * 128 + kk * 32 + q * 8;
            float s[8]; const u32x4 cur = *(const u32x4*)zp; float c0[8] = {blo(cur.x), bhi(cur.x), blo(cur.y), bhi(cur.y), blo(cur.z), bhi(cur.z), blo(cur.w), bhi(cur.w)};
#pragma unroll
            for (int j = 0; j < 8; ++j) s[j] = c0[j];
#pragma unroll 1
            for (int i = 1; i < w; ++i) { if (t - i >= 0) { const u32x4 v = *(const u32x4*)(zp - (size_t)i * LDZ);
                s[0] += blo(v.x); s[1] += bhi(v.x); s[2] += blo(v.y); s[3] += bhi(v.y); s[4] += blo(v.z); s[5] += bhi(v.z); s[6] += blo(v.w); s[7] += bhi(v.w); } }
            u32x4 pa; pa.x = pk2(s[0] * inv - c0[0], s[1] * inv - c0[1]); pa.y = pk2(s[2] * inv - c0[2], s[3] * inv - c0[3]); pa.z = pk2(s[4] * inv - c0[4], s[5] * inv - c0[5]); pa.w = pk2(s[6] * inv - c0[6], s[7] * inv - c0[7]);
            const bf16x8 a = __builtin_bit_cast(bf16x8, pa);
#pragma unroll
            for (int nt = 0; nt < 8; ++nt) acc[nt] = mma(ld8(PW + (size_t)(gi * 128 + nt * 16 + r) * 128 + kk * 32 + q * 8), a, acc[nt]); }
#pragma unroll
        for (int nt = 0; nt < 8; ++nt) { const int dcol = gi * 128 + nt * 16 + 4 * q; const f32x4 sc = *(const f32x4*)(pscale + dcol); const f32x4 o = acc[nt] * sc;
            u32x2 wv; wv.x = pk2(o[0], o[1]); wv.y = pk2(o[2], o[3]); *(u32x2*)(mixed + (size_t)t * D + 512 + dcol) = wv; }
    }
}
__device__ __forceinline__ void gla_gates(const bf16* z, const float* wa2, const float* ba, int h, int n, unsigned char* lds) {
    const int tid = tid_opaque(); float* bL = (float*)lds; float* glr = (float*)(lds + 32768); float* wa = (float*)(lds + 36864);
    for (int i = tid; i < 1024; i += 512) { const int t = i >> 4, c = i & 15; glr[i] = bf2f(z[(size_t)(n * 64 + t) * LDZ + Z_G + c]); }
    for (int i = tid; i < 2048; i += 512) { const int rr = i >> 7, d = i & 127; wa[i] = wa2[rr * 512 + h * 128 + d]; }
    __syncthreads();
    for (int i = tid; i < 8192; i += 512) { const int t = i >> 7, d = i & 127; float lg = ba[h * 128 + d];
#pragma unroll
        for (int rr = 0; rr < 16; ++rr) lg += glr[t * 16 + rr] * wa[rr * 128 + d];
        const float ls = fminf(lg, 0.f) - log1pf(__expf(-fabsf(lg))); bL[i] = ls * (1.0f / 16.0f); }
    __syncthreads();
    if (tid < 128) { float a = 0.f; for (int t = 0; t < 64; ++t) { a += bL[t * 128 + tid]; bL[t * 128 + tid] = a; } }
    __syncthreads();
}
__device__ __forceinline__ void gla_phase_a(KArgs A, int l, const bf16* z, float* ST, float* dec, unsigned char* lds) {
    const int tid = tid_opaque(), lane = tid & 63, wave = __builtin_amdgcn_readfirstlane(tid >> 6), r = lane & 15, q = lane >> 4;
    float* bL = (float*)lds; bf16* k2T = (bf16*)(lds + 45056); bf16* vT = (bf16*)(lds + 63488);
    for (int unit = blockIdx.x; unit < 4 * NCH; unit += gridDim.x) { const int h = unit & 3, n = unit >> 2;
        gla_gates(z, A->in[16] + (size_t)l * 16 * 512, A->in[17] + l * 512, h, n, lds);
        for (int i = tid; i < 8192; i += 512) { const int s = i >> 7, d = i & 127; const float kv = bf2f(z[(size_t)(n * 64 + s) * LDZ + Z_K + h * 128 + d]);
            k2T[d * 72 + s] = (bf16)f2bf(kv * __expf(bL[63 * 128 + d] - bL[s * 128 + d])); }
        for (int i = tid; i < 16384; i += 512) { const int s = i >> 8, v = i & 255; vT[v * 72 + s] = z[(size_t)(n * 64 + s) * LDZ + Z_V + h * 256 + v]; }
        if (tid < 128) dec[(size_t)(n * 4 + h) * 128 + tid] = __expf(bL[63 * 128 + tid]);
        __syncthreads();
        f32x4 acc[2][8];
#pragma unroll
        for (int i = 0; i < 2; ++i)
#pragma unroll
            for (int j = 0; j < 8; ++j) acc[i][j] = (f32x4){0.f, 0.f, 0.f, 0.f};
#pragma unroll
        for (int kk = 0; kk < 2; ++kk) { bf16x8 a[2];
#pragma unroll
            for (int mt = 0; mt < 2; ++mt) a[mt] = ld8(vT + (wave * 32 + mt * 16 + r) * 72 + kk * 32 + q * 8);
#pragma unroll
            for (int nt = 0; nt < 8; ++nt) { const bf16x8 b = ld8(k2T + (nt * 16 + r) * 72 + kk * 32 + q * 8);
#pragma unroll
                for (int mt = 0; mt < 2; ++mt) acc[mt][nt] = mma(b, a[mt], acc[mt][nt]); } }
        float* st = ST + (size_t)(n * 4 + h) * 32768;
#pragma unroll
        for (int mt = 0; mt < 2; ++mt)
#pragma unroll
            for (int nt = 0; nt < 8; ++nt) *(f32x4*)(st + (size_t)(wave * 32 + mt * 16 + r) * 128 + nt * 16 + 4 * q) = acc[mt][nt];
        __syncthreads();
    }
}
__device__ __forceinline__ void scan_phase(const unsigned char* wl, float* ST, const float* dec, const float* E, bf16* Sb) {
    const int tid = tid_opaque(), NGT = gridDim.x * 512;
    for (int e = blockIdx.x * 512 + tid; e < 131072; e += NGT) { const int h = e >> 15, d = e & 127; float S = 0.f; const float* dp = dec + h * 128 + d; float* sp = ST + e;
#pragma unroll 8
        for (int n = 0; n < NCH; ++n) { const float kv = sp[(size_t)n * 131072]; const float dc = dp[n * 512]; sp[(size_t)n * 131072] = S; S = dc * S + kv; } }
    const int wave = tid >> 6, lane = tid & 63;
    if (wave == 0) { const float* A16 = (const float*)(wl + L_A16);
        for (int g = blockIdx.x; g < 32; g += gridDim.x) { const float ar = A16[(g * 64 + lane) * 2], ai = A16[(g * 64 + lane) * 2 + 1]; float sr = 0.f, si = 0.f;
#pragma unroll 8
            for (int k = 0; k < S5NC; ++k) { const size_t o = ((size_t)k * 32 + g) * 128 + lane; const float er = E[o], ei = E[o + 64]; Sb[o] = (bf16)f2bf(sr); Sb[o + 64] = (bf16)f2bf(si);
                const float nr = ar * sr - ai * si + er, ni = ar * si + ai * sr + ei; sr = nr; si = ni; } } }
}
__device__ __forceinline__ void gla_phase_c(KArgs A, int l, const bf16* z, const float* ST, bf16* mixed, unsigned char* lds) {
    const int tid = tid_opaque(), lane = tid & 63, wave = __builtin_amdgcn_readfirstlane(tid >> 6), r = lane & 15, q = lane >> 4;
    float* bL = (float*)lds; bf16* qd = (bf16*)(lds + 45056); bf16* kd = (bf16*)(lds + 62464); bf16* vT = (bf16*)(lds + 79872); bf16* sc = (bf16*)(lds + 116736); float* red = (float*)(lds + 125952);
    const float* gnw = A->in[18] + l * 256;
    for (int unit = blockIdx.x; unit < 4 * NCH; unit += gridDim.x) { const int h = unit & 3, n = unit >> 2;
        gla_gates(z, A->in[16] + (size_t)l * 16 * 512, A->in[17] + l * 512, h, n, lds);
        for (int i = tid; i < 8192; i += 512) { const int t = i >> 7, d = i & 127; const size_t zo = (size_t)(n * 64 + t) * LDZ + h * 128 + d; const float b = bL[i];
            qd[t * 136 + d] = (bf16)f2bf(bf2f(z[zo + Z_Q]) * 0.08838834764831845f * __expf(b)); kd[t * 136 + d] = (bf16)f2bf(bf2f(z[zo + Z_K]) * __expf(-b)); }
        for (int i = tid; i < 16384; i += 512) { const int s = i >> 8, v = i & 255; vT[v * 72 + s] = z[(size_t)(n * 64 + s) * LDZ + Z_V + h * 256 + v]; }
        __syncthreads();
#pragma unroll
        for (int ti = 0; ti < 2; ++ti) { const int id = wave * 2 + ti, tm = id >> 2, tn = id & 3; f32x4 acc = (f32x4){0.f, 0.f, 0.f, 0.f};
            if (tn <= tm) {
#pragma unroll
                for (int kk = 0; kk < 4; ++kk) acc = mma(ld8(kd + (tn * 16 + r) * 136 + kk * 32 + q * 8), ld8(qd + (tm * 16 + r) * 136 + kk * 32 + q * 8), acc); }
            const int t = tm * 16 + r, s0 = tn * 16 + 4 * q; u32x2 w; w.x = pk2(s0 <= t ? acc[0] : 0.f, s0 + 1 <= t ? acc[1] : 0.f); w.y = pk2(s0 + 2 <= t ? acc[2] : 0.f, s0 + 3 <= t ? acc[3] : 0.f);
            *(u32x2*)(sc + t * 72 + s0) = w; }
        __syncthreads();
        const int tm = wave & 3, vh = wave >> 2; f32x4 acc[8];
#pragma unroll
        for (int i = 0; i < 8; ++i) acc[i] = (f32x4){0.f, 0.f, 0.f, 0.f};
#pragma unroll
        for (int kk = 0; kk < 2; ++kk) { const bf16x8 a = ld8(sc + (tm * 16 + r) * 72 + kk * 32 + q * 8);
#pragma unroll
            for (int nt = 0; nt < 8; ++nt) acc[nt] = mma(ld8(vT + (vh * 128 + nt * 16 + r) * 72 + kk * 32 + q * 8), a, acc[nt]); }
        const float* st = ST + (size_t)(n * 4 + h) * 32768;
#pragma unroll
        for (int kk = 0; kk < 4; ++kk) { const bf16x8 a = ld8(qd + (tm * 16 + r) * 136 + kk * 32 + q * 8);
#pragma unroll
            for (int nt = 0; nt < 8; ++nt) { const float* sp = st + (size_t)(vh * 128 + nt * 16 + r) * 128 + kk * 32 + q * 8; const f32x4 s0 = *(const f32x4*)sp, s1 = *(const f32x4*)(sp + 4);
                u32x4 pb; pb.x = pk2(s0[0], s0[1]); pb.y = pk2(s0[2], s0[3]); pb.z = pk2(s1[0], s1[1]); pb.w = pk2(s1[2], s1[3]);
                acc[nt] = mma(__builtin_bit_cast(bf16x8, pb), a, acc[nt]); } }
        float ss = 0.f;
#pragma unroll
        for (int nt = 0; nt < 8; ++nt) ss += (acc[nt][0] * acc[nt][0] + acc[nt][1] * acc[nt][1]) + (acc[nt][2] * acc[nt][2] + acc[nt][3] * acc[nt][3]);
        ss += __shfl_xor(ss, 16); ss += __shfl_xor(ss, 32);
        if (q == 0) red[vh * 64 + tm * 16 + r] = ss;
        __syncthreads();
        const float rstd = rsqrtf((red[tm * 16 + r] + red[64 + tm * 16 + r]) * (1.0f / 256.0f) + EPS);
        const size_t tok = (size_t)(n * 64 + tm * 16 + r);
#pragma unroll
        for (int nt = 0; nt < 8; ++nt) { const int v = vh * 128 + nt * 16 + 4 * q; const f32x4 nw = *(const f32x4*)(gnw + v); const u32x2 rv = *(const u32x2*)(z + tok * LDZ + Z_R + h * 256 + v);
            const float r0 = blo(rv.x), r1 = bhi(rv.x), r2 = blo(rv.y), r3 = bhi(rv.y);
            const float o0 = acc[nt][0] * rstd * nw[0] * r0 / (1.0f + __expf(-r0)), o1 = acc[nt][1] * rstd * nw[1] * r1 / (1.0f + __expf(-r1)),
                        o2 = acc[nt][2] * rstd * nw[2] * r2 / (1.0f + __expf(-r2)), o3 = acc[nt][3] * rstd * nw[3] * r3 / (1.0f + __expf(-r3));
            u32x2 w; w.x = pk2(o0, o1); w.y = pk2(o2, o3); *(u32x2*)(mixed + tok * D + 1024 + h * 256 + v) = w; }
        __syncthreads();
    }
}
__device__ __forceinline__ void fixup_phase(const float* cw, const float* cb, const float* headg, const float* headv, const float* tailg, bf16* act) {
    const int NGT = gridDim.x * 512;
    for (int i = blockIdx.x * 512 + tid_opaque(); i < 256 * 2 * DFF; i += NGT) { const int f = i % DFF, gr = i / DFF, rr = gr & 1, G = gr >> 1;
        const float g0 = headg[i], v = headv[i];
        const float tl1 = G > 0 ? tailg[((size_t)(G - 1) * 2 + 1) * DFF + f] : 0.f, tl0 = G > 0 ? tailg[((size_t)(G - 1) * 2) * DFF + f] : 0.f;
        const float gm1 = rr ? headg[((size_t)G * 2) * DFF + f] : tl1, gm2 = rr ? tl1 : tl0;
        const float gc = cb[f] + cw[f] * gm2 + cw[DFF + f] * gm1 + cw[2 * DFF + f] * g0;
        act[(size_t)(G * 64 + rr) * DFF + f] = (bf16)f2bf(gc / (1.0f + __expf(-gc)) * v); }
}
__device__ __forceinline__ void final_phase(float* out, const float* sq, const float* fw, int gw, int NGW, int lane) {
    for (int m = gw; m < M; m += NGW) { f32x4* xr = (f32x4*)(out + (size_t)m * D) + lane; const float rs = rsqrtf(sq[m] * (1.0f / D) + EPS);
#pragma unroll
        for (int j = 0; j < 8; ++j) { const f32x4 w = *((const f32x4*)fw + lane + 64 * j); f32x4 v = xr[64 * j]; v = v * rs * w; xr[64 * j] = v; } }
}

template <int PH> __device__ __forceinline__ void run_phase(unsigned char* lds) {
    pg8::PG8_LAS_T ldsl = (pg8::PG8_LAS_T)lds;
    const int tid = tid_opaque(), lane = tid & 63, wave = __builtin_amdgcn_readfirstlane(tid >> 6);
    const int G = gridDim.x, gw = blockIdx.x * 8 + wave, NGW = G * 8;
    KArgs A = (KArgs)__builtin_amdgcn_kernarg_segment_ptr(); asm volatile("" : "+s"(A));
    unsigned char* ws = A->ws; asm volatile("" : "+s"(ws));
    float* sq = (float*)(ws + WS_SQ); bf16* mixed = (bf16*)(ws + WS_MIX); bf16* z = (bf16*)(ws + WS_Z);
    float* ST = (float*)(ws + WS_ST); float* E = (float*)(ws + WS_E); bf16* Sb = (bf16*)(ws + WS_SB); bf16* ybuf = (bf16*)(ws + WS_Y); float* dec = (float*)(ws + WS_DEC);
    bf16* act = (bf16*)(ws + WS_ACT); float* headg = (float*)(ws + WS_HEADG); float* headv = (float*)(ws + WS_HEADV); float* tailg = (float*)(ws + WS_TAILG);
    if constexpr (PH == 0) { if (EN(10)) phase_prologue(A, lds); }
    else if constexpr (PH == NPHASE - 1) { if (EN(11)) final_phase(A->out, sq + 6 * M, A->in[28], gw, NGW, lane); }
    else {
        constexpr int l = (PH - 1) / 10, sp = (PH - 1) % 10; unsigned char* wl = ws + WS_L0 + (size_t)l * WS_LSTRIDE;
        const float* sq_mix = sq + (size_t)(3 * l) * M; float* sq_ffn = sq + (size_t)(3 * l + 1) * M; float* sq_ple = sq + (size_t)(3 * l + 2) * M; float* sq_nxt = sq + (size_t)(3 * l + 3) * M;
        bf16* hb_cur = (bf16*)(ws + (l == 0 ? WS_HB : WS_HB2)); bf16* hb_alt = (bf16*)(ws + (l == 0 ? WS_HB2 : WS_HB));
        pg8::StaticOrder S;
        if constexpr (sp == 0) { if (EN(0)) { pg8::Gemm g{hb_cur, (const bf16*)(wl + L_WIN), M, LDZ, D}; S.init(M, LDZ, G, (int)blockIdx.x); pg8::EpiScaleBf16 Ep{z, LDZ, sq_mix, 1.0f / D};
                  pg8::gemm_phase<pg8::EpiScaleBf16, pg8::StaticOrder, true, true>(ldsl, g, S, Ep); } }
        else if constexpr (sp == 1) { if (EN(1)) { if (SUB & 1) s5_phase_a(wl, z, E, gw, NGW, lane); if (SUB & 2) pool_phase(wl, z, A->in[15] + l * 512, mixed, gw, NGW, lane); if (SUB & 4) gla_phase_a(A, l, z, ST, dec, lds); } }
        else if constexpr (sp == 2) { if (EN(2)) { scan_phase(wl, ST, dec, E, Sb); } }
        else if constexpr (sp == 3) { if (EN(3)) { if (SUB & 1) s5_phase_c(wl, z, Sb, A->in[11] + l * 512, ybuf, gw, NGW, lane); if (SUB & 2) gla_phase_c(A, l, z, ST, mixed, lds); } }
        else if constexpr (sp == 4) { if (EN(4)) { pg8::Gemm g{ybuf, (const bf16*)(wl + L_WGLU), M, 512, 512}; S.init(M, 512, G, (int)blockIdx.x); pg8::EpiGlu Ep{ybuf, A->in[13] + l * 512, mixed};
                  pg8::gemm_phase<pg8::EpiGlu, pg8::StaticOrder, true, true>(ldsl, g, S, Ep); } }
        else if constexpr (sp == 5) { if (EN(5)) { pg8::Gemm g{mixed, (const bf16*)(wl + L_WOUT), M, D, D}; S.init(M, D, G, (int)blockIdx.x); pg8::EpiRes Ep{l == 0 ? A->in[0] : A->out, A->out, hb_alt, sq_ffn};
                  pg8::gemm_phase<pg8::EpiRes, pg8::StaticOrder, true, true>(ldsl, g, S, Ep); } }
        else if constexpr (sp == 6) { if (EN(6)) { pg8::Gemm g{hb_alt, (const bf16*)(wl + L_WUP), M, NUP, D}; S.init(M, NUP, G, (int)blockIdx.x);
                  pg8::EpiUp Ep{act, sq_ffn, A->in[22] + (size_t)l * 3 * DFF, A->in[23] + l * DFF, headg, headv, tailg};
                  pg8::gemm_phase<pg8::EpiUp, pg8::StaticOrder, true, true>(ldsl, g, S, Ep); } }
        else if constexpr (sp == 7) { if (EN(7)) { if (SUB & 1) fixup_phase(A->in[22] + (size_t)l * 3 * DFF, A->in[23] + l * DFF, headg, headv, tailg, act);
                  int Kp = PLED; asm volatile("" : "+s"(Kp)); pg8::Gemm g{(const bf16*)(ws + WS_PB) + (size_t)l * M * PLED, (const bf16*)(wl + L_WPLE), M, D, Kp}; S.init(M, D, G, (int)blockIdx.x); pg8::EpiScaleBf16 Ep{mixed, D, nullptr, 0.f};
                  pg8::gemm_phase<pg8::EpiScaleBf16, pg8::StaticOrder, true, true>(ldsl, g, S, Ep); } }
        else if constexpr (sp == 8) { if (EN(8)) { pg8::Gemm g{act, (const bf16*)(wl + L_WDN), M, D, DFF}; S.init(M, D, G, (int)blockIdx.x); pg8::EpiRes Ep{A->out, A->out, hb_cur, sq_ple};
                  pg8::gemm_phase<pg8::EpiRes, pg8::StaticOrder, true, true>(ldsl, g, S, Ep); } }
        else { if (EN(9)) { pg8::Gemm g{hb_cur, (const bf16*)(wl + L_WPG), M, D, D}; S.init(M, D, G, (int)blockIdx.x); pg8::EpiPg Ep{A->out, A->out, hb_alt, sq_nxt, sq_ple, mixed};
                  pg8::gemm_phase<pg8::EpiPg, pg8::StaticOrder, true, true>(ldsl, g, S, Ep); } }
    }
}
__global__ void __launch_bounds__(512, 2) hymba_fwd(Args args) {
    extern __shared__ __attribute__((aligned(16))) unsigned char lds[];
    const int lo = args.ph_lo, hi = args.ph_hi;
#define RUN(k) if (lo <= (k) && (k) < hi) { if ((k) != lo) cg::this_grid().sync(); run_phase<(k)>(lds); }
    RUN(0) RUN(1) RUN(2) RUN(3) RUN(4) RUN(5) RUN(6) RUN(7) RUN(8) RUN(9) RUN(10)
    RUN(11) RUN(12) RUN(13) RUN(14) RUN(15) RUN(16) RUN(17) RUN(18) RUN(19) RUN(20) RUN(21)
#undef RUN
}

#ifndef N_LAUNCH_MODE
#define N_LAUNCH_MODE 1
#endif
extern "C" void kernel_launch(void* const* d_in, const int* in_sizes, int n_in, void* d_out, int out_size, void* d_ws, size_t ws_size, hipStream_t stream) {
    static int grid = 0;
    if (grid == 0) {
        if (n_in != 29 || out_size != M * D || ws_size < WS_END) { fprintf(stderr, "kernel_launch: unexpected shapes (n_in %d out %d ws %zu need %zu)\n", n_in, out_size, ws_size, (size_t)WS_END); grid = -1; return; }
        int dev = 0, cus = 0, per_cu = 0;
        if (hipGetDevice(&dev) != hipSuccess || hipDeviceGetAttribute(&cus, hipDeviceAttributeMultiprocessorCount, dev) != hipSuccess) { grid = -1; return; }
        if (hipFuncSetAttribute((const void*)hymba_fwd, hipFuncAttributeMaxDynamicSharedMemorySize, LDS_BYTES) != hipSuccess) { fprintf(stderr, "kernel_launch: hipFuncSetAttribute failed\n"); grid = -1; return; }
        if (hipOccupancyMaxActiveBlocksPerMultiprocessor(&per_cu, (const void*)hymba_fwd, 512, LDS_BYTES) != hipSuccess || per_cu < 1) { fprintf(stderr, "kernel_launch: occupancy query says %d\n", per_cu); per_cu = 1; }
        (void)hipGetLastError();
        grid = cus * per_cu;
    }
    if (grid < 0) return;
    Args a{};
    for (int i = 0; i < 29; ++i) a.in[i] = (const float*)d_in[i];
    a.out = (float*)d_out; a.ws = (unsigned char*)d_ws;
#if N_LAUNCH_MODE == 1
    for (int ph = 0; ph < NPHASE; ++ph) { a.ph_lo = ph; a.ph_hi = ph + 1; hipLaunchKernelGGL(hymba_fwd, dim3(grid), dim3(512), LDS_BYTES, stream, a); }
#else
    a.ph_lo = 0; a.ph_hi = NPHASE;
    void* kargs[] = {&a};
    hipError_t e = hipLaunchCooperativeKernel((const void*)hymba_fwd, dim3(grid), dim3(512), kargs, LDS_BYTES, stream);
    if (e != hipSuccess) fprintf(stderr, "kernel_launch: cooperative launch failed: %s (grid %d)\n", hipGetErrorString(e), grid);
#endif
}
```

```cpp
#include <hip/hip_runtime.h>
#include <hip/hip_cooperative_groups.h>
#include <cstdio>
#include <cstdint>
namespace cg = cooperative_groups;
namespace pg8 {
#define PG8_LAS __attribute__((address_space(3)))
typedef unsigned short bf16_t;
typedef short bf16x8 __attribute__((ext_vector_type(8)));
typedef float f32x4 __attribute__((ext_vector_type(4)));
typedef unsigned u32x4 __attribute__((ext_vector_type(4)));
constexpr int BM = 256, BK = 64, HALF = 128, HTB = HALF * BK * 2  , STAGE_BYTES = 8 * HTB, NXCD = 8, WGM = 8;

__host__ __device__ __forceinline__ int lds_byte(int r, int c) { const int st = (r >> 4) * 2 + (c >> 5), rr = r & 15, cc = c & 31, ob = rr * 64 + cc * 2; return st * 1024 + (ob ^ (((ob >> 9) & 1) << 5)); }
__host__ __device__ __forceinline__ void stage_rc(int b, int& R, int& C) { const int st = b / 1024, sb = b % 1024, swz = sb ^ (((sb >> 9) & 1) << 5); R = (st >> 1) * 16 + swz / 64; C = (st & 1) * 32 + (swz % 64) / 2; }
__host__ __device__ __forceinline__ int perm32(int rho) { const int n = rho >> 4, i = rho & 15; return 8 * (i >> 2) + 4 * n + (i & 3); }

struct Unit { int pm, pn; };
struct Gemm { const bf16_t* A; const bf16_t* Bt; int M, N, K; };

struct StaticOrder {
    int nM, nN, nwg, G, c;
    __host__ __device__ void init(int M, int N, int G_, int c_) { nM = M / BM; nN = N / BM; nwg = nM * nN; G = G_; c = c_; }
    __host__ __device__ bool next(int i, Unit& u) const {
        const long L = (long)i * G + c; if (L >= nwg) return false;
        int wgid = (int)L; { const int q = nwg / NXCD, r = nwg % NXCD, xcd = wgid % NXCD, off = wgid / NXCD; wgid = (xcd < r ? xcd * (q + 1) : r * (q + 1) + (xcd - r) * q) + off; }
        const int nig = WGM * nN, gid = wgid / nig, fm = gid * WGM, gsz = (nM - fm) < WGM ? (nM - fm) : WGM;
        u.pm = fm + ((wgid % nig) % gsz); u.pn = (wgid % nig) / gsz; return true;
    }
    __device__ __forceinline__ void a_ready(const Unit&) const {}
    __device__ __forceinline__ void done(const Unit&) const {}
};
typedef PG8_LAS unsigned char* PG8_LAS_T;

__device__ __forceinline__ unsigned cvt_pk_bf16(float lo, float hi) { unsigned r; asm volatile("v_cvt_pk_bf16_f32 %0, %1, %2" : "=v"(r) : "v"(lo), "v"(hi)); return r; }
typedef unsigned u32x2 __attribute__((ext_vector_type(2)));
constexpr float RMS_EPS = 1e-6f;
constexpr int DM = 2048, DFF = 5632;
__device__ __forceinline__ float sigm(float x) { return __builtin_amdgcn_rcpf(1.0f + __expf(-x)); }
__device__ __forceinline__ float bflo(unsigned u) { return __uint_as_float(u << 16); }
__device__ __forceinline__ float bfhi(unsigned u) { return __uint_as_float(u & 0xffff0000u); }

struct EpiScaleBf16 {
    static constexpr bool PERM = true, AFTER_DRAIN = false;
    bf16_t* O; int ldc; const float* rowsq; float inv_n;
    __device__ __forceinline__ void operator()(const f32x4 (&acc)[2][2][4][2], const Unit& u, int wr, int wc, int fr, int fq) const {
        const int row0 = u.pm * BM + wr * 64 + fr, col0 = u.pn * BM + wc * 32 + 8 * fq;
        float rq[2][4];
#pragma unroll
        for (int ai = 0; ai < 2; ++ai)
#pragma unroll
            for (int m = 0; m < 4; ++m) rq[ai][m] = rowsq ? rowsq[row0 + ai * HALF + m * 16] : 0.f;
#pragma unroll
        for (int ai = 0; ai < 2; ++ai)
#pragma unroll
            for (int m = 0; m < 4; ++m) { const int row = row0 + ai * HALF + m * 16; const float rs = rowsq ? rsqrtf(rq[ai][m] * inv_n + RMS_EPS) : 1.0f;
                bf16_t* rowp = O + (size_t)row * ldc + col0;
#pragma unroll
                for (int bj = 0; bj < 2; ++bj) { const f32x4 v0 = acc[ai][bj][m][0] * rs, v1 = acc[ai][bj][m][1] * rs;
                    u32x4 w; w.x = cvt_pk_bf16(v0[0], v0[1]); w.y = cvt_pk_bf16(v0[2], v0[3]); w.z = cvt_pk_bf16(v1[0], v1[1]); w.w = cvt_pk_bf16(v1[2], v1[3]);
                    *(u32x4*)(rowp + bj * HALF) = w; } }
    }
};

struct EpiRes {
    static constexpr bool PERM = false, AFTER_DRAIN = false;
    const float* base; float* out; bf16_t* hb; float* sq_next;
    __device__ __forceinline__ void operator()(const f32x4 (&acc)[2][2][4][2], const Unit& u, int wr, int wc, int fr, int fq) const {
        const int row0 = u.pm * BM + wr * 64 + fr, col0 = u.pn * BM + wc * 32 + 4 * fq;
#pragma unroll
        for (int ai = 0; ai < 2; ++ai) {
            f32x4 bs[4][2][2];
#pragma unroll
            for (int m = 0; m < 4; ++m)
#pragma unroll
                for (int bj = 0; bj < 2; ++bj)
#pragma unroll
                    for (int n = 0; n < 2; ++n) bs[m][bj][n] = *(const f32x4*)(base + (size_t)(row0 + ai * HALF + m * 16) * DM + col0 + bj * HALF + n * 16);
#pragma unroll
            for (int m = 0; m < 4; ++m) { const int row = row0 + ai * HALF + m * 16; const size_t off = (size_t)row * DM + col0; float ss = 0.f;
#pragma unroll
                for (int bj = 0; bj < 2; ++bj)
#pragma unroll
                    for (int n = 0; n < 2; ++n) { const size_t o2 = off + bj * HALF + n * 16; const f32x4 o = bs[m][bj][n] + acc[ai][bj][m][n];
                        *(f32x4*)(out + o2) = o; u32x2 w; w.x = cvt_pk_bf16(o[0], o[1]); w.y = cvt_pk_bf16(o[2], o[3]); *(u32x2*)(hb + o2) = w;
                        ss += (o[0] * o[0] + o[1] * o[1]) + (o[2] * o[2] + o[3] * o[3]); }
                ss += __shfl_xor(ss, 16); ss += __shfl_xor(ss, 32);
                if (fq == 0) unsafeAtomicAdd(sq_next + row, ss); }
            asm volatile("" ::: "memory"); }
    }
};

struct EpiPg {
    static constexpr bool PERM = false, AFTER_DRAIN = false;
    const float* base; float* out; bf16_t* hb; float* sq_next; const float* rowsq; const bf16_t* ple;
    __device__ __forceinline__ void operator()(const f32x4 (&acc)[2][2][4][2], const Unit& u, int wr, int wc, int fr, int fq) const {
        const int row0 = u.pm * BM + wr * 64 + fr, col0 = u.pn * BM + wc * 32 + 4 * fq;
#pragma unroll
        for (int ai = 0; ai < 2; ++ai)
#pragma unroll
            for (int mh = 0; mh < 2; ++mh) {
                f32x4 bs[2][2][2]; u32x2 pl[2][2][2]; float rs[2];
#pragma unroll
                for (int mm = 0; mm < 2; ++mm) { const int row = row0 + ai * HALF + (mh * 2 + mm) * 16; rs[mm] = rowsq[row];
#pragma unroll
                    for (int bj = 0; bj < 2; ++bj)
#pragma unroll
                        for (int n = 0; n < 2; ++n) { const size_t o2 = (size_t)row * DM + col0 + bj * HALF + n * 16; bs[mm][bj][n] = *(const f32x4*)(base + o2); pl[mm][bj][n] = *(const u32x2*)(ple + o2); } }
#pragma unroll
                for (int mm = 0; mm < 2; ++mm) { const int m = mh * 2 + mm; const int row = row0 + ai * HALF + m * 16; const size_t off = (size_t)row * DM + col0; float ss = 0.f;
                    const float r = rsqrtf(rs[mm] * (1.0f / DM) + RMS_EPS);
#pragma unroll
                    for (int bj = 0; bj < 2; ++bj)
#pragma unroll
                        for (int n = 0; n < 2; ++n) { const size_t o2 = off + bj * HALF + n * 16; const f32x4 b = bs[mm][bj][n]; const u32x2 p = pl[mm][bj][n];
                            const f32x4 a = acc[ai][bj][m][n] * r; f32x4 o;
                            o[0] = b[0] + bflo(p.x) * sigm(a[0]); o[1] = b[1] + bfhi(p.x) * sigm(a[1]); o[2] = b[2] + bflo(p.y) * sigm(a[2]); o[3] = b[3] + bfhi(p.y) * sigm(a[3]);
                            *(f32x4*)(out + o2) = o; u32x2 w; w.x = cvt_pk_bf16(o[0], o[1]); w.y = cvt_pk_bf16(o[2], o[3]); *(u32x2*)(hb + o2) = w;
                            ss += (o[0] * o[0] + o[1] * o[1]) + (o[2] * o[2] + o[3] * o[3]); }
                    ss += __shfl_xor(ss, 16); ss += __shfl_xor(ss, 32);
                    if (fq == 0) unsafeAtomicAdd(sq_next + row, ss); }
                asm volatile("" ::: "memory"); }
    }
};

struct EpiGlu {
    static constexpr bool PERM = true, AFTER_DRAIN = false;
    const bf16_t* ybuf; const float* bias; bf16_t* O;
    __device__ __forceinline__ void operator()(const f32x4 (&acc)[2][2][4][2], const Unit& u, int wr, int wc, int fr, int fq) const {
        const int row0 = u.pm * BM + wr * 64 + fr, col0 = u.pn * BM + wc * 32 + 8 * fq;
#pragma unroll
        for (int ai = 0; ai < 2; ++ai)
#pragma unroll
            for (int m = 0; m < 4; ++m) { const int row = row0 + ai * HALF + m * 16;
#pragma unroll
                for (int bj = 0; bj < 2; ++bj) { const int c = col0 + bj * HALF; const u32x4 yv = *(const u32x4*)(ybuf + (size_t)row * 512 + c);
                    const f32x4 b0 = *(const f32x4*)(bias + c), b1 = *(const f32x4*)(bias + c + 4); const f32x4 a0 = acc[ai][bj][m][0] + b0, a1 = acc[ai][bj][m][1] + b1;
                    u32x4 w; w.x = cvt_pk_bf16(bflo(yv.x) * sigm(a0[0]), bfhi(yv.x) * sigm(a0[1])); w.y = cvt_pk_bf16(bflo(yv.y) * sigm(a0[2]), bfhi(yv.y) * sigm(a0[3]));
                    w.z = cvt_pk_bf16(bflo(yv.z) * sigm(a1[0]), bfhi(yv.z) * sigm(a1[1])); w.w = cvt_pk_bf16(bflo(yv.w) * sigm(a1[2]), bfhi(yv.w) * sigm(a1[3]));
                    *(u32x4*)(O + (size_t)row * DM + c) = w; } }
    }
};

struct EpiUp {
    static constexpr bool PERM = true, AFTER_DRAIN = false;
    bf16_t* act; const float* rowsq; const float* cw; const float* cb; float* headg; float* headv; float* tailg;
    __device__ __forceinline__ void operator()(const f32x4 (&acc)[2][2][4][2], const Unit& u, int wr, int wc, int fr, int fq) const {
        const int row0 = u.pm * BM + wr * 64 + fr, f00 = u.pn * HALF + wc * 32 + 8 * fq;
        const int lane = (int)(threadIdx.x & 63); const int src1 = (lane & 48) | ((fr + 15) & 15), src2 = (lane & 48) | ((fr + 14) & 15);
        float rq[2][4]; f32x4 cwv[2][4];
#pragma unroll
        for (int ai = 0; ai < 2; ++ai)
#pragma unroll
            for (int m = 0; m < 4; ++m) rq[ai][m] = rowsq[row0 + ai * HALF + m * 16];
#pragma unroll
        for (int n = 0; n < 2; ++n) { const int f0 = f00 + 4 * n; cwv[n][0] = *(const f32x4*)(cw + f0); cwv[n][1] = *(const f32x4*)(cw + DFF + f0); cwv[n][2] = *(const f32x4*)(cw + 2 * DFF + f0); cwv[n][3] = *(const f32x4*)(cb + f0); }
#pragma unroll
        for (int ai = 0; ai < 2; ++ai) {
            float rs[4];
#pragma unroll
            for (int m = 0; m < 4; ++m) rs[m] = rsqrtf(rq[ai][m] * (1.0f / DM) + RMS_EPS);
            const int G = u.pm * 4 + ai * 2 + wr;
#pragma unroll
            for (int n = 0; n < 2; ++n) { const int f0 = f00 + 4 * n;
                const f32x4 w0 = cwv[n][0], w1 = cwv[n][1], w2 = cwv[n][2], bb = cwv[n][3];
                f32x4 r1p = (f32x4){0.f, 0.f, 0.f, 0.f}, r2p = r1p;
#pragma unroll
                for (int m = 0; m < 4; ++m) { const int row = row0 + ai * HALF + m * 16;
                    const f32x4 g = acc[ai][0][m][n] * rs[m], v = acc[ai][1][m][n] * rs[m]; f32x4 r1, r2;
#pragma unroll
                    for (int j = 0; j < 4; ++j) { r1[j] = __shfl(g[j], src1); r2[j] = __shfl(g[j], src2); }
                    f32x4 p1, p2;
#pragma unroll
                    for (int j = 0; j < 4; ++j) { p1[j] = fr >= 1 ? r1[j] : r1p[j]; p2[j] = fr >= 2 ? r2[j] : r2p[j]; }
                    if (m == 0 && fr < 2) { *(f32x4*)(headg + ((size_t)G * 2 + fr) * DFF + f0) = g; *(f32x4*)(headv + ((size_t)G * 2 + fr) * DFF + f0) = v; }
                    else { f32x4 gc = bb + w0 * p2 + w1 * p1 + w2 * g; f32x4 a;
#pragma unroll
                        for (int j = 0; j < 4; ++j) a[j] = gc[j] * sigm(gc[j]) * v[j];
                        u32x2 w; w.x = cvt_pk_bf16(a[0], a[1]); w.y = cvt_pk_bf16(a[2], a[3]); *(u32x2*)(act + (size_t)row * DFF + f0) = w; }
                    if (m == 3 && fr >= 14) *(f32x4*)(tailg + ((size_t)G * 2 + (fr - 14)) * DFF + f0) = g;
                    r1p = r1; r2p = r2; }
            }
        }
    }
};

struct EpiNull {
    static constexpr bool PERM = true, AFTER_DRAIN = false;
    __device__ __forceinline__ void operator()(const f32x4 (&acc)[2][2][4][2], const Unit& u, int wr, int wc, int fr, int fq) const {
#pragma unroll
        for (int ai = 0; ai < 2; ++ai)
#pragma unroll
            for (int bj = 0; bj < 2; ++bj)
#pragma unroll
                for (int m = 0; m < 4; ++m)
#pragma unroll
                    for (int n = 0; n < 2; ++n) asm volatile("" :: "v"(acc[ai][bj][m][n]));
    }
};

template <class Epi, class Sched, bool ALIGN_EPI = false, bool SP2 = false>
__device__ __forceinline__ void gemm_phase(PG8_LAS unsigned char* lds, const Gemm g, const Sched& S, const Epi& E) {
    int tid_l = threadIdx.x; asm volatile("" : "+v"(tid_l)); const int tid = tid_l, wid = __builtin_amdgcn_readfirstlane(tid >> 6), lane = tid & 63, wr = wid >> 2, wc = wid & 3, fr = lane & 15, fq = lane >> 4;
    const int K = g.K, nt = K / BK;
    unsigned voffA[2], voffB[2];
#pragma unroll
    for (int i = 0; i < 2; ++i) { int R, C; stage_rc(tid * 16 + i * 8192, R, C); const int Rb = Epi::PERM ? ((R & ~31) + perm32(R & 31)) : R;
        voffA[i] = (unsigned)(R * K + C) * 2u; voffB[i] = (unsigned)(Rb * K + C) * 2u; }
    const size_t kstep = (size_t)(BK * 2);
    const size_t hstep = (size_t)HALF * K * 2;
    const size_t tstep = 2 * hstep;
    const unsigned ldsw = (unsigned)wid * 1024u;
    const int aoff = lds_byte(wr * 64 + fr, fq * 8), boff = lds_byte(wc * 32 + fr, fq * 8);
#define PG8_SA(b, h) (((b) * 2 + (h)) * HTB)
#define PG8_SB(b, h) ((4 + (b) * 2 + (h)) * HTB)
#define PG8_STAGE(bufoff, gbase, voff) do { _Pragma("unroll") for (int _i = 0; _i < 2; ++_i) \
        __builtin_amdgcn_global_load_lds((const unsigned*)((const char*)(gbase) + (voff)[_i]), (PG8_LAS unsigned*)(lds + (bufoff) + ldsw + _i * 8192), 16, 0, 0); } while (0)
#define PG8_LDA(dst, b, h) do { _Pragma("unroll") for (int m = 0; m < 4; ++m) _Pragma("unroll") for (int k = 0; k < 2; ++k) dst[m][k] = *(const PG8_LAS bf16x8*)(lds + PG8_SA(b, h) + aoff + m * 2048 + k * 1024); } while (0)
#define PG8_LDB(dst, b, h) do { _Pragma("unroll") for (int n = 0; n < 2; ++n) _Pragma("unroll") for (int k = 0; k < 2; ++k) dst[n][k] = *(const PG8_LAS bf16x8*)(lds + PG8_SB(b, h) + boff + n * 2048 + k * 1024); } while (0)
#define PG8_MMA(ai, bj, At, Bt) do { __builtin_amdgcn_s_setprio(1); _Pragma("unroll") for (int m = 0; m < 4; ++m) _Pragma("unroll") for (int n = 0; n < 2; ++n) _Pragma("unroll") for (int k = 0; k < 2; ++k) \
        acc[ai][bj][m][n] = __builtin_amdgcn_mfma_f32_16x16x32_bf16(Bt[n][k], At[m][k], acc[ai][bj][m][n], 0, 0, 0); __builtin_amdgcn_s_setprio(0); } while (0)
#define PG8_WAIT_V(n) asm volatile("s_waitcnt vmcnt(" #n ")" ::: "memory")
#define PG8_WAIT_L(n) asm volatile("s_waitcnt lgkmcnt(" #n ")" ::: "memory")
#define PG8_BAR __builtin_amdgcn_s_barrier()
#define PG8_SCHED __builtin_amdgcn_sched_barrier(0)
    Unit cur, nxt; int ui = 0;
    if (!S.next(0, cur)) return;
    f32x4 acc[2][2][4][2];
#pragma unroll
    for (int a = 0; a < 2; ++a)
#pragma unroll
        for (int b = 0; b < 2; ++b)
#pragma unroll
            for (int m = 0; m < 4; ++m)
#pragma unroll
                for (int n = 0; n < 2; ++n) acc[a][b][m][n] = (f32x4){0.f, 0.f, 0.f, 0.f};
    bf16x8 At[4][2], B0[2][2], B1[2][2];
    const char* cA = (const char*)g.A + (size_t)cur.pm * tstep; const char* cB = (const char*)g.Bt + (size_t)cur.pn * tstep;
    S.a_ready(cur);
    if constexpr (SP2) {
        PG8_STAGE(PG8_SB(0, 0), cB, voffB); PG8_STAGE(PG8_SB(0, 1), cB + hstep, voffB); PG8_STAGE(PG8_SA(0, 0), cA, voffA); PG8_STAGE(PG8_SA(0, 1), cA + hstep, voffA);
        if (wr == 1) PG8_BAR;
        PG8_WAIT_V(2); PG8_BAR;
        PG8_STAGE(PG8_SB(1, 0), cB + kstep, voffB); PG8_STAGE(PG8_SA(1, 0), cA + kstep, voffA); PG8_STAGE(PG8_SB(1, 1), cB + hstep + kstep, voffB);
        PG8_WAIT_V(6); PG8_BAR;
    } else {
        PG8_STAGE(PG8_SB(0, 0), cB, voffB); PG8_STAGE(PG8_SA(0, 0), cA, voffA); PG8_STAGE(PG8_SB(0, 1), cB + hstep, voffB); PG8_STAGE(PG8_SA(0, 1), cA + hstep, voffA);
        if (wr == 1) PG8_BAR;
        PG8_WAIT_V(4); PG8_BAR;
        PG8_STAGE(PG8_SB(1, 0), cB + kstep, voffB); PG8_STAGE(PG8_SA(1, 0), cA + kstep, voffA); PG8_STAGE(PG8_SB(1, 1), cB + hstep + kstep, voffB);
        PG8_WAIT_V(6); PG8_BAR;
    }
    for (;;) {
        const bool has_next = S.next(ui + 1, nxt);
        const char* nA = has_next ? (const char*)g.A + (size_t)nxt.pm * tstep : cA; const char* nB = has_next ? (const char*)g.Bt + (size_t)nxt.pn * tstep : cB;
        for (int t = 0; t < nt; t += 2) {
            const bool last = (t == nt - 2);
            const char* a1 = cA + (size_t)(t + 1) * kstep;
            const char* a2 = last ? nA : cA + (size_t)(t + 2) * kstep; const char* b2 = last ? nB : cB + (size_t)(t + 2) * kstep;
            const char* a3 = a2 + kstep; const char* b3 = b2 + kstep;
            if (last && has_next) S.a_ready(nxt);
            if constexpr (SP2) {
            PG8_LDB(B0, 0, 0); PG8_LDB(B1, 0, 1); PG8_SCHED; PG8_LDA(At, 0, 0); PG8_STAGE(PG8_SA(1, 1), a1 + hstep, voffA);
            PG8_WAIT_V(8); PG8_WAIT_L(0); PG8_BAR; PG8_MMA(0, 0, At, B0); PG8_MMA(0, 1, At, B1); PG8_BAR; PG8_SCHED;
            PG8_LDA(At, 0, 1); PG8_STAGE(PG8_SB(0, 0), b2, voffB); PG8_STAGE(PG8_SB(0, 1), b2 + hstep, voffB); PG8_STAGE(PG8_SA(0, 0), a2, voffA);
            PG8_WAIT_V(8); PG8_WAIT_L(0); PG8_BAR; PG8_MMA(1, 0, At, B0); PG8_MMA(1, 1, At, B1); PG8_BAR; PG8_SCHED;
            PG8_LDB(B0, 1, 0); PG8_LDB(B1, 1, 1); PG8_SCHED; PG8_LDA(At, 1, 0); PG8_STAGE(PG8_SA(0, 1), a2 + hstep, voffA);
            PG8_WAIT_V(8); PG8_WAIT_L(0); PG8_BAR; PG8_MMA(0, 0, At, B0); PG8_MMA(0, 1, At, B1); PG8_BAR; PG8_SCHED;
            PG8_LDA(At, 1, 1); PG8_STAGE(PG8_SB(1, 0), b3, voffB); PG8_STAGE(PG8_SB(1, 1), b3 + hstep, voffB); PG8_STAGE(PG8_SA(1, 0), a3, voffA);
            PG8_WAIT_V(8); PG8_WAIT_L(0); PG8_BAR; PG8_MMA(1, 0, At, B0); PG8_MMA(1, 1, At, B1); PG8_BAR; PG8_SCHED;
            } else {
            PG8_LDB(B0, 0, 0); PG8_SCHED; PG8_LDA(At, 0, 0); PG8_STAGE(PG8_SA(1, 1), a1 + hstep, voffA);
            PG8_WAIT_L(8); PG8_BAR; PG8_WAIT_L(0); PG8_MMA(0, 0, At, B0); PG8_BAR; PG8_SCHED;
            PG8_LDB(B1, 0, 1); PG8_STAGE(PG8_SB(0, 0), b2, voffB);
            PG8_BAR; PG8_WAIT_L(0); PG8_MMA(0, 1, At, B1); PG8_BAR;
            PG8_LDA(At, 0, 1); PG8_STAGE(PG8_SA(0, 0), a2, voffA);
            PG8_BAR; PG8_WAIT_L(0); PG8_MMA(1, 0, At, B0); PG8_BAR; PG8_SCHED;
            PG8_STAGE(PG8_SB(0, 1), b2 + hstep, voffB);
            PG8_WAIT_V(6); PG8_BAR; PG8_MMA(1, 1, At, B1); PG8_BAR;
            PG8_LDB(B0, 1, 0); PG8_SCHED; PG8_LDA(At, 1, 0); PG8_STAGE(PG8_SA(0, 1), a2 + hstep, voffA);
            PG8_WAIT_L(8); PG8_BAR; PG8_WAIT_L(0); PG8_MMA(0, 0, At, B0); PG8_BAR; PG8_SCHED;
            PG8_LDB(B1, 1, 1); PG8_STAGE(PG8_SB(1, 0), b3, voffB);
            PG8_BAR; PG8_WAIT_L(0); PG8_MMA(0, 1, At, B1); PG8_BAR;
            PG8_LDA(At, 1, 1); PG8_STAGE(PG8_SA(1, 0), a3, voffA);
            PG8_BAR; PG8_WAIT_L(0); PG8_MMA(1, 0, At, B0); PG8_BAR; PG8_SCHED;
            PG8_STAGE(PG8_SB(1, 1), b3 + hstep, voffB);
            PG8_WAIT_V(6); PG8_BAR; PG8_MMA(1, 1, At, B1); PG8_BAR;
            }
        }
        if constexpr (ALIGN_EPI) { if (wr == 0) PG8_BAR; }
        if constexpr (!Epi::AFTER_DRAIN) { E(acc, cur, wr, wc, fr, fq); S.done(cur); }
        if (!has_next) break;
#pragma unroll
        for (int a = 0; a < 2; ++a)
#pragma unroll
            for (int b = 0; b < 2; ++b)
#pragma unroll
                for (int m = 0; m < 4; ++m)
#pragma unroll
                    for (int n = 0; n < 2; ++n) acc[a][b][m][n] = (f32x4){0.f, 0.f, 0.f, 0.f};
        cur = nxt; cA = nA; cB = nB; ++ui;
        if constexpr (ALIGN_EPI) { if (wr == 1) PG8_BAR; }
    }
    PG8_WAIT_V(0);
    if constexpr (!ALIGN_EPI) { if (wr == 0) PG8_BAR; }
    PG8_BAR;
    if constexpr (Epi::AFTER_DRAIN) { E.fused(acc, cur, wr, wc, fr, fq, lds, wid, lane); S.done(cur); }
#undef PG8_SA
#undef PG8_SB
#undef PG8_STAGE
#undef PG8_LDA
#undef PG8_LDB
#undef PG8_MMA
#undef PG8_WAIT_V
#undef PG8_WAIT_L
#undef PG8_BAR
#undef PG8_SCHED
}
}

typedef unsigned short bf16;
typedef short bf16x8 __attribute__((ext_vector_type(8)));
typedef float f32x4 __attribute__((ext_vector_type(4)));
typedef unsigned u32x4 __attribute__((ext_vector_type(4)));
typedef unsigned u32x2 __attribute__((ext_vector_type(2)));
constexpr int M = 16384, D = 2048, NIN = 4112, NZ = 4096, LDZ = 4160, DFF = 5632, NUP = 11264, PLED = 256;
constexpr int Z_POOL = 512, Z_Q = 1024, Z_K = 1536, Z_V = 2048, Z_R = 3072;
constexpr int NCH = 256;
constexpr int S5T = 16, S5NC = 1024;
constexpr float EPS = 1e-6f;
constexpr size_t MiB = 1u << 20;
constexpr size_t WS_SQ = 0, WS_BAR = 512 * 1024, WS_CNT = WS_BAR + 16384;
constexpr size_t WS_L0 = 1 * MiB, WS_LSTRIDE = 110 * MiB;
constexpr size_t L_WIN = 0, L_WG = 16 * MiB, L_WOUT = 17 * MiB, L_WUP = 25 * MiB, L_WDN = 69 * MiB, L_WPG = 91 * MiB, L_WPLE = 99 * MiB, L_WGLU = 100 * MiB, L_POOLW = 100 * MiB + 512 * 1024,
                 L_PT = 101 * MiB, L_QT = 103 * MiB, L_BT = 105 * MiB, L_A16 = 109 * MiB;
constexpr size_t WS_HB = 221 * MiB, WS_PB = 285 * MiB, WS_MIX = 301 * MiB, WS_R1 = 365 * MiB;
constexpr size_t WS_Z = WS_R1, WS_ST = WS_R1 + 136 * MiB, WS_E = WS_ST + 128 * MiB, WS_SB = WS_E + 16 * MiB, WS_Y = WS_SB + 8 * MiB, WS_DEC = WS_Y + 16 * MiB;
constexpr size_t WS_ACT = WS_R1, WS_HEADG = WS_R1 + 176 * MiB, WS_HEADV = WS_HEADG + 11 * MiB, WS_TAILG = WS_HEADV + 11 * MiB;
constexpr size_t WS_HB2 = WS_R1 + 209 * MiB;
constexpr size_t WS_GLR = WS_DEC + 1 * MiB;
constexpr size_t WS_END = WS_GLR + 1 * MiB;
constexpr int LDS_BYTES = 147456;
constexpr int NPHASE = 20;
#ifndef PHASE_MASK
#define PHASE_MASK 0xFFF
#endif
#define EN(x) ((PHASE_MASK >> (x)) & 1)
#ifndef SUB
#define SUB 7
#endif
#ifndef REPSUB
#define REPSUB 7
#endif

__device__ __forceinline__ unsigned f2bf(float f) { unsigned u = __float_as_uint(f); return (u + 0x7fffu + ((u >> 16) & 1u)) >> 16; }
__device__ __forceinline__ unsigned pk2(float lo, float hi) { return f2bf(lo) | (f2bf(hi) << 16); }
__device__ __forceinline__ float bf2f(bf16 b) { return __uint_as_float(((unsigned)b) << 16); }
__device__ __forceinline__ float blo(unsigned u) { return __uint_as_float(u << 16); }
__device__ __forceinline__ float bhi(unsigned u) { return __uint_as_float(u & 0xffff0000u); }
__device__ __forceinline__ bf16x8 ld8(const bf16* p) { return *(const bf16x8*)p; }
__device__ __forceinline__ f32x4 mma(bf16x8 b, bf16x8 a, f32x4 c) { return __builtin_amdgcn_mfma_f32_16x16x32_bf16(b, a, c, 0, 0, 0); }
__device__ __forceinline__ float wave_sum(float v) {
#pragma unroll
    for (int o = 1; o < 64; o <<= 1) v += __shfl_xor(v, o);
    return v;
}
__device__ __forceinline__ float gelu_tanh(float x) { const float y = 0.7978845608f * (x + 0.044715f * x * x * x); const float e = __expf(2.0f * y); return x * (1.0f - __builtin_amdgcn_rcpf(e + 1.0f)); }

__device__ __forceinline__ int tid_opaque() { int t = threadIdx.x; asm volatile("" : "+v"(t)); return t; }
struct Args { const float* in[29]; float* out; unsigned char* ws; int ph_lo, ph_hi; };
typedef const __attribute__((address_space(4))) Args* KArgs;

__device__ __forceinline__ void transpose_item(const float* W, int ldw, int nvalid, const float* kscale, bf16* WT, int ldt, int drow0, int k0, int n0, float* scr, int lane) {
    const int nn = n0 + lane; const bool ok = nn < nvalid; const float* wp = W + (size_t)k0 * ldw + nn;
    float tv[64];
#pragma unroll
    for (int kk = 0; kk < 64; ++kk) tv[kk] = ok ? wp[(size_t)kk * ldw] : 0.f;
#pragma unroll
    for (int kk = 0; kk < 64; ++kk) { float v = tv[kk]; if (kscale) v *= kscale[k0 + kk]; scr[kk * 65 + lane] = v; }
    asm volatile("s_waitcnt lgkmcnt(0)" ::: "memory");
    const int c = lane & 7;
#pragma unroll
    for (int j = 0; j < 8; ++j) { const int n = (lane >> 3) + 8 * j; const float* sp = scr + (8 * c) * 65 + n;
        u32x4 o; o.x = pk2(sp[0 * 65], sp[1 * 65]); o.y = pk2(sp[2 * 65], sp[3 * 65]); o.z = pk2(sp[4 * 65], sp[5 * 65]); o.w = pk2(sp[6 * 65], sp[7 * 65]);
        *(u32x4*)(WT + (size_t)(drow0 + n) * ldt + k0 + 8 * c) = o; }
    asm volatile("s_waitcnt lgkmcnt(0)" ::: "memory");
}

__device__ __forceinline__ void s5_precompute(KArgs A, int l, int g, unsigned char* wl, float* L) {
    const int tid = tid_opaque(); const int lg = l * 32 + g;
    float* powr = L; float* powi = L + 1088; float* Bbr = L + 2176; float* Bbi = L + 3200; float* Cr = L + 4224; float* Ci = L + 5248; float* Km = L + 6272;
    const float* a_re = A->in[4] + lg * 64; const float* a_im = A->in[5] + lg * 64;
    const double dt = (double)expf(A->in[6][lg]);
    for (int idx = tid; idx < 17 * 64; idx += 512) { const int d = idx >> 6, n = idx & 63;
        const double ang = (double)a_im[n] * dt * d, mag = exp((double)a_re[n] * dt * d); powr[idx] = (float)(mag * cos(ang)); powi[idx] = (float)(mag * sin(ang)); }
    for (int idx = tid; idx < 1024; idx += 512) { const int n = idx >> 4, c = idx & 15;
        const double are = a_re[n], aim = a_im[n], zr = are * dt, zi = aim * dt, e = exp(zr), er = e * cos(zi) - 1.0, ei = e * sin(zi), den = are * are + aim * aim;
        const double fr = (er * are + ei * aim) / den, fi = (ei * are - er * aim) / den;
        const double br = A->in[7][(size_t)(lg * 64 + n) * 16 + c], bi = A->in[8][(size_t)(lg * 64 + n) * 16 + c];
        Bbr[idx] = (float)(fr * br - fi * bi); Bbi[idx] = (float)(fr * bi + fi * br); }
    for (int idx = tid; idx < 1024; idx += 512) { Cr[idx] = A->in[9][(size_t)lg * 1024 + idx]; Ci[idx] = A->in[10][(size_t)lg * 1024 + idx]; }
    __syncthreads();
    for (int idx = tid; idx < 4096; idx += 512) { const int d = idx >> 8, cp = (idx >> 4) & 15, c = idx & 15; float s = 0.f;
        for (int n = 0; n < 64; ++n) { const float cr = Cr[cp * 64 + n], ci = Ci[cp * 64 + n], pr = powr[d * 64 + n], pi = powi[d * 64 + n];
            const float wr = cr * pr - ci * pi, wi = cr * pi + ci * pr; s += wr * Bbr[n * 16 + c] - wi * Bbi[n * 16 + c]; }
        Km[idx] = s; }
    __syncthreads();
    bf16* Pt = (bf16*)(wl + L_PT) + (size_t)g * 128 * 256; bf16* QT = (bf16*)(wl + L_QT) + (size_t)g * 256 * 128; bf16* BT = (bf16*)(wl + L_BT) + (size_t)g * 256 * 256; float* A16 = (float*)(wl + L_A16) + g * 128;
    for (int idx = tid; idx < 32768; idx += 512) { const int np = idx >> 8, j = idx & 255, s = j >> 4, c = j & 15, n = np & 63;
        const float pr = powr[(15 - s) * 64 + n], pi = powi[(15 - s) * 64 + n], br = Bbr[n * 16 + c], bi = Bbi[n * 16 + c];
        Pt[idx] = (bf16)f2bf(np < 64 ? (pr * br - pi * bi) : (pr * bi + pi * br)); }
    for (int idx = tid; idx < 32768; idx += 512) { const int nn = idx >> 7, np = idx & 127, t = nn >> 4, cp = nn & 15, n = np & 63;
        const float pr = powr[(t + 1) * 64 + n], pi = powi[(t + 1) * 64 + n], cr = Cr[cp * 64 + n], ci = Ci[cp * 64 + n];
        QT[idx] = (bf16)f2bf(np < 64 ? (cr * pr - ci * pi) : -(cr * pi + ci * pr)); }
    for (int idx = tid; idx < 65536; idx += 512) { const int nn = idx >> 8, j = idx & 255, t = nn >> 4, cp = nn & 15, s = j >> 4, c = j & 15;
        BT[idx] = (bf16)f2bf(s <= t ? Km[(t - s) * 256 + cp * 16 + c] : 0.f); }
    if (tid < 64) { A16[tid * 2] = powr[16 * 64 + tid]; A16[tid * 2 + 1] = powi[16 * 64 + tid]; }
    __syncthreads();
}

__device__ __forceinline__ void phase_prologue(KArgs A, unsigned char* lds) {
    const int tid = tid_opaque(), lane = tid & 63, wave = __builtin_amdgcn_readfirstlane(tid >> 6);
    const int G = gridDim.x, gw = blockIdx.x * 8 + wave, NGW = G * 8, gt = blockIdx.x * 512 + tid, NGT = G * 512;
    unsigned char* ws = A->ws;
    for (int it = blockIdx.x; it < 64; it += G) s5_precompute(A, it >> 5, it & 31, ws + WS_L0 + (size_t)(it >> 5) * WS_LSTRIDE, (float*)lds);
    const bool skip64 = G >= 128; const int NGW2 = skip64 ? (G - 64) * 8 : NGW, NGT2 = skip64 ? (G - 64) * 512 : NGT;
    const int gw2 = skip64 ? ((int)blockIdx.x >= 64 ? gw - 512 : M) : gw, gt2 = skip64 ? ((int)blockIdx.x >= 64 ? gt - 64 * 512 : 2 * M * PLED) : gt;
    { float* sq = (float*)(ws + WS_SQ); for (int i = gt; i < 6 * M; i += NGT) sq[M + i] = 0.f; }
    { const f32x4* p4 = (const f32x4*)A->in[1]; u32x2* o = (u32x2*)(ws + WS_PB);
#pragma unroll 8
      for (int i = gt2; i < 2 * M * PLED / 4; i += NGT2) { const f32x4 v = p4[i]; u32x2 w; w.x = pk2(v[0], v[1]); w.y = pk2(v[2], v[3]); o[i] = w; } }
    { float* sq = (float*)(ws + WS_SQ); bf16* hb = (bf16*)(ws + WS_HB);
      for (int m = gw2; m < M; m += 2 * NGW2) { const int m2 = (m + NGW2 < M) ? m + NGW2 : m;
          const f32x4* xr = (const f32x4*)(A->in[0] + (size_t)m * D) + lane; const f32x4* xr2 = (const f32x4*)(A->in[0] + (size_t)m2 * D) + lane; f32x4 v[8], v2[8];
#pragma unroll
          for (int j = 0; j < 8; ++j) { v[j] = xr[64 * j]; v2[j] = xr2[64 * j]; }
          u32x2* o = (u32x2*)(hb + (size_t)m * D) + lane; u32x2* o2 = (u32x2*)(hb + (size_t)m2 * D) + lane; float s = 0.f, s2 = 0.f;
#pragma unroll
          for (int j = 0; j < 8; ++j) { s += (v[j][0] * v[j][0] + v[j][1] * v[j][1]) + (v[j][2] * v[j][2] + v[j][3] * v[j][3]); u32x2 w; w.x = pk2(v[j][0], v[j][1]); w.y = pk2(v[j][2], v[j][3]); o[64 * j] = w;
              s2 += (v2[j][0] * v2[j][0] + v2[j][1] * v2[j][1]) + (v2[j][2] * v2[j][2] + v2[j][3] * v2[j][3]); u32x2 w2; w2.x = pk2(v2[j][0], v2[j][1]); w2.y = pk2(v2[j][2], v2[j][3]); o2[64 * j] = w2; }
          s = wave_sum(s); s2 = wave_sum(s2); if (lane == 0) { sq[m] = s; sq[m2] = s2; } } }
    float* scr = (float*)(lds + wave * 16640);
    constexpr int I_IN = 32 * 65, I_OUT = 32 * 32, I_UP = 32 * 176, I_DN = 88 * 32, I_PG = 32 * 32, I_PLE = 4 * 32, I_GLU = 8 * 8, I_POOL = 16;
    constexpr int I_LAYER = I_IN + I_OUT + I_UP + I_DN + I_PG + I_PLE + I_GLU + I_POOL;
    for (int it = gw; it < 2 * I_LAYER; it += NGW) {
        const int l = it >= I_LAYER ? 1 : 0; int r = it - l * I_LAYER; unsigned char* wl = ws + WS_L0 + (size_t)l * WS_LSTRIDE;
        if (r < I_IN) { const int kb = r / 65, nb = r % 65; const float* W = A->in[3] + (size_t)l * D * NIN; const float* ks = A->in[2] + l * D;
            if (nb < 48) transpose_item(W, NIN, NIN, ks, (bf16*)(wl + L_WIN), D, 64 * nb, 64 * kb, 64 * nb, scr, lane);
            else if (nb == 48) transpose_item(W, NIN, 3088, ks, (bf16*)(wl + L_WG), D, 0, 64 * kb, 3072, scr, lane);
            else transpose_item(W, NIN, NIN, ks, (bf16*)(wl + L_WIN), D, 3072 + 64 * (nb - 49), 64 * kb, 3088 + 64 * (nb - 49), scr, lane);
            continue; } r -= I_IN;
        if (r < I_OUT) { const int kb = r / 32, nb = r % 32; transpose_item(A->in[19] + (size_t)l * D * D, D, D, nullptr, (bf16*)(wl + L_WOUT), D, 64 * nb, 64 * kb, 64 * nb, scr, lane); continue; } r -= I_OUT;
        if (r < I_UP) { const int kb = r / 176, nb = r % 176, n0 = 64 * nb, isv = n0 >= DFF ? 1 : 0, f = n0 - isv * DFF, drow = (f >> 7) * 256 + isv * 128 + (f & 127);
            transpose_item(A->in[21] + (size_t)l * D * NUP, NUP, NUP, A->in[20] + l * D, (bf16*)(wl + L_WUP), D, drow, 64 * kb, n0, scr, lane); continue; } r -= I_UP;
        if (r < I_DN) { const int kb = r / 32, nb = r % 32; transpose_item(A->in[24] + (size_t)l * DFF * D, D, D, nullptr, (bf16*)(wl + L_WDN), DFF, 64 * nb, 64 * kb, 64 * nb, scr, lane); continue; } r -= I_DN;
        if (r < I_PG) { const int kb = r / 32, nb = r % 32; transpose_item(A->in[27] + (size_t)l * D * D, D, D, A->in[25] + l * D, (bf16*)(wl + L_WPG), D, 64 * nb, 64 * kb, 64 * nb, scr, lane); continue; } r -= I_PG;
        if (r < I_PLE) { const int kb = r / 32, nb = r % 32; transpose_item(A->in[26] + (size_t)l * PLED * D, D, D, nullptr, (bf16*)(wl + L_WPLE), PLED, 64 * nb, 64 * kb, 64 * nb, scr, lane); continue; } r -= I_PLE;
        if (r < I_GLU) { const int kb = r / 8, nb = r % 8; transpose_item(A->in[12] + (size_t)l * 512 * 512, 512, 512, nullptr, (bf16*)(wl + L_WGLU), 512, 64 * nb, 64 * kb, 64 * nb, scr, lane); continue; } r -= I_GLU;
        { const int gi = r >> 2, kb = (r >> 1) & 1, nb = r & 1; transpose_item(A->in[14] + (size_t)(l * 4 + gi) * 128 * 128, 128, 128, nullptr, (bf16*)(wl + L_POOLW) + gi * 128 * 128, 128, 64 * nb, 64 * kb, 64 * nb, scr, lane); }
    }
}

__device__ __forceinline__ void glr_phase(const unsigned char* wl, const bf16* hb, const float* rowsq, float* glr, int gw, int NGW, int lane) {
    const int r = lane & 15, q = lane >> 4; const bf16* WG = (const bf16*)(wl + L_WG);
    for (int task = gw; task < M / 16; task += NGW) { const int t = task * 16 + r; f32x4 acc = (f32x4){0.f, 0.f, 0.f, 0.f};
        const bf16* arow = hb + (size_t)t * D + q * 8; const bf16* brow = WG + (size_t)r * D + q * 8;
#pragma unroll 16
        for (int kk = 0; kk < D / 32; ++kk) acc = mma(ld8(brow + kk * 32), ld8(arow + kk * 32), acc);
        const float rs = rsqrtf(rowsq[t] * (1.0f / D) + EPS);
        *(f32x4*)(glr + (size_t)t * 16 + 4 * q) = acc * rs; }
}

__device__ __forceinline__ void s5_phase_a(const unsigned char* wl, const bf16* z, float* E, int gw, int NGW, int lane) {
    const int r = lane & 15, q = lane >> 4; const bf16* Pt = (const bf16*)(wl + L_PT);
    for (int task = gw; task < 2048; task += NGW) { const int g = task & 31, mb = task >> 5, k = mb * 16 + r;
        f32x4 acc[8];
#pragma unroll
        for (int i = 0; i < 8; ++i) acc[i] = (f32x4){0.f, 0.f, 0.f, 0.f};
        const bf16* arow = z + (size_t)(k * 16) * LDZ + g * 16 + (size_t)(q >> 1) * LDZ + (q & 1) * 8;
        const bf16* brow = Pt + (size_t)(g * 128 + r) * 256 + q * 8;
#pragma unroll 4
        for (int kk = 0; kk < 8; ++kk) { const bf16x8 a = ld8(arow + (size_t)(2 * kk) * LDZ); const bf16* bp = brow + kk * 32;
#pragma unroll
            for (int nt = 0; nt < 8; ++nt) acc[nt] = mma(ld8(bp + (size_t)nt * 16 * 256), a, acc[nt]); }
#pragma unroll
        for (int nt = 0; nt < 8; ++nt) *(f32x4*)(E + ((size_t)k * 32 + g) * 128 + nt * 16 + 4 * q) = acc[nt];
    }
}
__device__ __forceinline__ void s5_phase_c(const unsigned char* wl, const bf16* z, const bf16* Sb, const float* dskip, bf16* ybuf, unsigned char* lds) {
    const int tid = tid_opaque(), lane = tid & 63, wave = __builtin_amdgcn_readfirstlane(tid >> 6), r = lane & 15, q = lane >> 4;
    const bf16* QT = (const bf16*)(wl + L_QT); const bf16* BT = (const bf16*)(wl + L_BT); bf16* Bs = (bf16*)lds;
    for (int tb = blockIdx.x; tb < 256; tb += gridDim.x) { const int g = tb & 31, mb = (tb >> 5) * 8 + wave, k = mb * 16 + r;
        f32x4 acc[16];
#pragma unroll
        for (int i = 0; i < 16; ++i) acc[i] = (f32x4){0.f, 0.f, 0.f, 0.f};
        const bf16* srow = Sb + ((size_t)k * 32 + g) * 128 + q * 8; const bf16* arow = z + (size_t)(k * 16) * LDZ + g * 16 + (size_t)(q >> 1) * LDZ + (q & 1) * 8;
        const int nn0 = tid >> 2, part = tid & 3;
        const bf16* q0 = QT + (size_t)(g * 256 + nn0) * 128 + part * 8; const bf16* b0 = BT + (size_t)(g * 256 + nn0) * 256 + part * 8;
        u32x4 pb0 = *(const u32x4*)q0, pb1 = *(const u32x4*)(q0 + (size_t)128 * 128); bf16x8 pa = ld8(srow);
#pragma unroll 1
        for (int kk = 0; kk < 12; ++kk) { bf16* buf = Bs + (kk & 1) * (256 * 40);
            *(u32x4*)(buf + nn0 * 40 + part * 8) = pb0; *(u32x4*)(buf + (nn0 + 128) * 40 + part * 8) = pb1; const bf16x8 a = pa;
            __syncthreads();
            if (kk + 1 < 12) { const int k1 = kk + 1;
                if (k1 < 4) { pb0 = *(const u32x4*)(q0 + k1 * 32); pb1 = *(const u32x4*)(q0 + (size_t)128 * 128 + k1 * 32); pa = ld8(srow + k1 * 32); }
                else { pb0 = *(const u32x4*)(b0 + (k1 - 4) * 32); pb1 = *(const u32x4*)(b0 + (size_t)128 * 256 + (k1 - 4) * 32); pa = ld8(arow + (size_t)(2 * (k1 - 4)) * LDZ); } }
            const int smin = kk < 4 ? 0 : 2 * (kk - 4);
#pragma unroll
            for (int nt = 0; nt < 16; ++nt) if (nt >= smin) acc[nt] = mma(ld8(buf + (nt * 16 + r) * 40 + q * 8), a, acc[nt]);
        }
        const f32x4 dsk = *(const f32x4*)(dskip + g * 16 + 4 * q);
#pragma unroll
        for (int nt = 0; nt < 16; ++nt) { const size_t tok = (size_t)k * 16 + nt; const u32x2 uv = *(const u32x2*)(z + tok * LDZ + g * 16 + 4 * q);
            const float y0 = gelu_tanh(acc[nt][0] + dsk[0] * blo(uv.x)), y1 = gelu_tanh(acc[nt][1] + dsk[1] * bhi(uv.x)), y2 = gelu_tanh(acc[nt][2] + dsk[2] * blo(uv.y)), y3 = gelu_tanh(acc[nt][3] + dsk[3] * bhi(uv.y));
            u32x2 w; w.x = pk2(y0, y1); w.y = pk2(y2, y3); *(u32x2*)(ybuf + tok * 512 + g * 16 + 4 * q) = w; }
        __syncthreads();
    }
}
__device__ __forceinline__ void pool_phase(const unsigned char* wl, const bf16* z, const float* pscale, bf16* mixed, unsigned* ctr, int lane) {
    const int r = lane & 15, q = lane >> 4; const bf16* PW = (const bf16*)(wl + L_POOLW);
    for (;;) { unsigned tk = 0u; if (lane == 0) tk = __hip_atomic_fetch_add(ctr, 1u, __ATOMIC_RELAXED, __HIP_MEMORY_SCOPE_AGENT); const int task = __builtin_amdgcn_readfirstlane((int)tk); if (task >= 4096) break; { const int gi = (task >> 3) & 3, tb = (task >> 5) * 8 + (task & 7), t = tb * 16 + r, w = 2 << gi; const int cnt = (t + 1) < w ? (t + 1) : w; const float inv = 1.0f / (float)cnt;
        f32x4 acc[8];
#pragma unroll
        for (int i = 0; i < 8; ++i) acc[i] = (f32x4){0.f, 0.f, 0.f, 0.f};
#pragma unroll 2
        for (int kk = 0; kk < 4; ++kk) { const bf16* zp = z + (size_t)t * LDZ + Z_POOL + gi * 128 + kk * 32 + q * 8;
            float s[8]; const u32x4 cur = *(const u32x4*)zp; float c0[8] = {blo(cur.x), bhi(cur.x), blo(cur.y), bhi(cur.y), blo(cur.z), bhi(cur.z), blo(cur.w), bhi(cur.w)};
#pragma unroll
            for (int j = 0; j < 8; ++j) s[j] = c0[j];
#pragma unroll
            for (int i = 1; i < 16; ++i) { if (i < w && t - i >= 0) { const u32x4 v = *(const u32x4*)(zp - (size_t)i * LDZ);
                s[0] += blo(v.x); s[1] += bhi(v.x); s[2] += blo(v.y); s[3] += bhi(v.y); s[4] += blo(v.z); s[5] += bhi(v.z); s[6] += blo(v.w); s[7] += bhi(v.w); } }
            u32x4 pa; pa.x = pk2(s[0] * inv - c0[0], s[1] * inv - c0[1]); pa.y = pk2(s[2] * inv - c0[2], s[3] * inv - c0[3]); pa.z = pk2(s[4] * inv - c0[4], s[5] * inv - c0[5]); pa.w = pk2(s[6] * inv - c0[6], s[7] * inv - c0[7]);
            const bf16x8 a = __builtin_bit_cast(bf16x8, pa);
#pragma unroll
            for (int nt = 0; nt < 8; ++nt) acc[nt] = mma(ld8(PW + (size_t)(gi * 128 + nt * 16 + r) * 128 + kk * 32 + q * 8), a, acc[nt]); }
#pragma unroll
        for (int nt = 0; nt < 8; ++nt) { const int dcol = gi * 128 + nt * 16 + 4 * q; const f32x4 sc = *(const f32x4*)(pscale + dcol); const f32x4 o = acc[nt] * sc;
            u32x2 wv; wv.x = pk2(o[0], o[1]); wv.y = pk2(o[2], o[3]); *(u32x2*)(mixed + (size_t)t * D + 512 + dcol) = wv; }
    } }
}
__device__ __forceinline__ void gla_gates(const float* ba, int h, unsigned char* lds, int tid) {
    float* bL = (float*)lds; float* glr = (float*)(lds + 32768); float* wa = (float*)(lds + 36864); float* part = (float*)(lds + 45056);
    { const int d = tid & 127; const float bias = ba[h * 128 + d]; float w[16];
#pragma unroll
      for (int rr = 0; rr < 16; ++rr) w[rr] = wa[rr * 128 + d];
#pragma unroll 4
      for (int j = 0; j < 16; ++j) { const int t = (tid >> 7) + 4 * j; float lg = bias;
#pragma unroll
          for (int rr = 0; rr < 16; ++rr) lg += glr[t * 16 + rr] * w[rr];
          const float ls = fminf(lg, 0.f) - __logf(1.0f + __expf(-fabsf(lg))); bL[t * 128 + d] = ls * (1.0f / 16.0f); } }
    __syncthreads();
    { const int seg = tid >> 7, d = tid & 127; float a = 0.f;
#pragma unroll
      for (int t = 0; t < 16; ++t) { a += bL[(seg * 16 + t) * 128 + d]; bL[(seg * 16 + t) * 128 + d] = a; }
      part[seg * 128 + d] = a; }
    __syncthreads();
    { const int seg = tid >> 7, d = tid & 127; float off = 0.f;
      for (int s2 = 0; s2 < seg; ++s2) off += part[s2 * 128 + d];
      if (seg > 0) {
#pragma unroll
          for (int t = 0; t < 16; ++t) bL[(seg * 16 + t) * 128 + d] += off; } }
    __syncthreads();
}
__device__ __forceinline__ size_t vt_off(int n, int h, int v) { return (size_t)(n * 64 + (v >> 2)) * LDZ + Z_V + 256 * h + 64 * (v & 3); }
__device__ __forceinline__ void gla_phase_a(KArgs A, int l, bf16* z, const float* glrg, float* ST, float* dec, unsigned char* lds) {
    const int tid = tid_opaque(), lane = tid & 63, wave = __builtin_amdgcn_readfirstlane(tid >> 6), r = lane & 15, q = lane >> 4;
    float* bL = (float*)lds; bf16* k2T = (bf16*)(lds + 47104); bf16* vT = (bf16*)(lds + 65536);
    const float* wa2 = A->in[16] + (size_t)l * 16 * 512; float* glrL = (float*)(lds + 32768); float* waL = (float*)(lds + 36864);
    u32x4 vpre[4], qpre[2], kpre[2], nv[4], nq[2], nk[2]; float cg[2], cw[4], ng[2], nw4[4];
#define GLA_LOAD(U, Q, K, V, GG, WW) do { const int h_ = (U) & 3, n_ = (U) >> 2; \
        _Pragma("unroll") for (int j = 0; j < 2; ++j) { const int i = tid + j * 512, t = i >> 4, d0 = (i & 15) * 8; const bf16* qp_ = z + (size_t)(n_ * 64 + t) * LDZ + Z_Q + h_ * 128 + d0; Q[j] = *(const u32x4*)qp_; K[j] = *(const u32x4*)(qp_ + (Z_K - Z_Q)); GG[j] = glrg[(size_t)n_ * 1024 + i]; } \
        _Pragma("unroll") for (int j = 0; j < 4; ++j) { const int i = tid + j * 512, s_ = i >> 5, v0 = (i & 31) * 8; V[j] = *(const u32x4*)(z + (size_t)(n_ * 64 + s_) * LDZ + Z_V + h_ * 256 + v0); WW[j] = wa2[(i >> 7) * 512 + h_ * 128 + (i & 127)]; } } while (0)
    if ((int)blockIdx.x < 4 * NCH) GLA_LOAD((int)blockIdx.x, qpre, kpre, vpre, cg, cw);
    for (int unit = blockIdx.x; unit < 4 * NCH; unit += gridDim.x) { const int h = unit & 3, n = unit >> 2;
#pragma unroll
        for (int j = 0; j < 2; ++j) glrL[tid + j * 512] = cg[j];
#pragma unroll
        for (int j = 0; j < 4; ++j) waL[tid + j * 512] = cw[j];
        __syncthreads();
        const int nu = unit + (int)gridDim.x; const bool has_next = nu < 4 * NCH;
        if (has_next) GLA_LOAD(nu, nq, nk, nv, ng, nw4);
        gla_gates(A->in[17] + l * 512, h, lds, tid);
#pragma unroll
        for (int j = 0; j < 2; ++j) { const int i = tid + j * 512, t = i >> 4, d0 = (i & 15) * 8; bf16* qp = z + (size_t)(n * 64 + t) * LDZ + Z_Q + h * 128 + d0; bf16* kp = qp + (Z_K - Z_Q);
            const u32x4 qv = qpre[j], kv = kpre[j]; const unsigned qa[4] = {qv.x, qv.y, qv.z, qv.w}, ka[4] = {kv.x, kv.y, kv.z, kv.w}; unsigned qo[4], ko[4];
#pragma unroll
            for (int e = 0; e < 4; ++e) { const float b0 = bL[t * 128 + d0 + 2 * e], b1 = bL[t * 128 + d0 + 2 * e + 1], bl0 = bL[63 * 128 + d0 + 2 * e], bl1 = bL[63 * 128 + d0 + 2 * e + 1];
                const float e0 = __expf(b0), e1 = __expf(b1), k0 = blo(ka[e]), k1 = bhi(ka[e]);
                qo[e] = pk2(blo(qa[e]) * 0.08838834764831845f * e0, bhi(qa[e]) * 0.08838834764831845f * e1); ko[e] = pk2(k0 * __expf(-b0), k1 * __expf(-b1));
                k2T[(d0 + 2 * e) * 72 + ((t + d0) & 63)] = (bf16)f2bf(k0 * __expf(bl0 - b0)); k2T[(d0 + 2 * e + 1) * 72 + ((t + d0) & 63)] = (bf16)f2bf(k1 * __expf(bl1 - b1)); }
            u32x4 qw; qw.x = qo[0]; qw.y = qo[1]; qw.z = qo[2]; qw.w = qo[3]; u32x4 kw; kw.x = ko[0]; kw.y = ko[1]; kw.z = ko[2]; kw.w = ko[3];
            *(u32x4*)qp = qw; *(u32x4*)kp = kw; }
#pragma unroll
        for (int j = 0; j < 4; ++j) { const int i = tid + j * 512, s = i >> 5, v0 = (i & 31) * 8; const u32x4 vv = vpre[j];
            const unsigned va[4] = {vv.x, vv.y, vv.z, vv.w};
#pragma unroll
            for (int e = 0; e < 4; ++e) { vT[(v0 + 2 * e) * 72 + ((s + v0) & 63)] = (bf16)(va[e] & 0xffffu); vT[(v0 + 2 * e + 1) * 72 + ((s + v0) & 63)] = (bf16)(va[e] >> 16); } }
        if (tid < 128) dec[(size_t)(n * 4 + h) * 128 + tid] = __expf(bL[63 * 128 + tid]);
        __syncthreads();
#pragma unroll
        for (int j = 0; j < 4; ++j) { const int i = tid + j * 512, v = i >> 3, c = i & 7; *(u32x4*)(z + vt_off(n, h, v) + 8 * c) = *(const u32x4*)(vT + v * 72 + ((8 * c + 8 * (v >> 3)) & 63)); }
        f32x4 acc[2][8];
#pragma unroll
        for (int i = 0; i < 2; ++i)
#pragma unroll
            for (int j = 0; j < 8; ++j) acc[i][j] = (f32x4){0.f, 0.f, 0.f, 0.f};
#pragma unroll
        for (int kk = 0; kk < 2; ++kk) { bf16x8 a[2];
#pragma unroll
            for (int mt = 0; mt < 2; ++mt) { const int vr = wave * 32 + mt * 16 + r; a[mt] = ld8(vT + vr * 72 + ((kk * 32 + q * 8 + 8 * (vr >> 3)) & 63)); }
#pragma unroll
            for (int nt = 0; nt < 8; ++nt) { const int dr = nt * 16 + r; const bf16x8 b = ld8(k2T + dr * 72 + ((kk * 32 + q * 8 + 8 * (dr >> 3)) & 63));
#pragma unroll
                for (int mt = 0; mt < 2; ++mt) acc[mt][nt] = mma(b, a[mt], acc[mt][nt]); } }
        bf16* st = (bf16*)ST + (size_t)(n * 4 + h) * 32768;
#pragma unroll
        for (int mt = 0; mt < 2; ++mt)
#pragma unroll
            for (int nt = 0; nt < 8; ++nt) { u32x2 w; w.x = pk2(acc[mt][nt][0], acc[mt][nt][1]); w.y = pk2(acc[mt][nt][2], acc[mt][nt][3]); *(u32x2*)(st + (size_t)(wave * 32 + mt * 16 + r) * 128 + nt * 16 + 4 * q) = w; }
        __syncthreads();
        if (has_next) {
#pragma unroll
            for (int j = 0; j < 2; ++j) { qpre[j] = nq[j]; kpre[j] = nk[j]; cg[j] = ng[j]; }
#pragma unroll
            for (int j = 0; j < 4; ++j) { vpre[j] = nv[j]; cw[j] = nw4[j]; } }
    }
#undef GLA_LOAD
}
__device__ __forceinline__ void scan_phase(const unsigned char* wl, float* ST, const float* dec, const float* E, bf16* Sb, unsigned char* lds) {
    const int tid = tid_opaque(), NGT = gridDim.x * 512;
    const int wave = __builtin_amdgcn_readfirstlane(tid >> 6), lane = tid & 63;
    const bool split = gridDim.x >= 160;
    const int g0 = split ? (int)blockIdx.x - 128 : (int)blockIdx.x, gstep = split ? 32 : (int)gridDim.x;
    if (g0 >= 0) { const float* A16 = (const float*)(wl + L_A16); float* X = (float*)lds;
      for (int g = g0; g < 32; g += gstep) { const float ar = A16[(g * 64 + lane) * 2], ai = A16[(g * 64 + lane) * 2 + 1]; float sr = 0.f, si = 0.f;
          const int k0 = wave * 128;
#pragma unroll 16
          for (int k = 0; k < 128; ++k) { const size_t o = ((size_t)(k0 + k) * 32 + g) * 128 + lane; const float er = E[o], ei = E[o + 64];
              const float nr = ar * sr - ai * si + er, ni = ar * si + ai * sr + ei; sr = nr; si = ni; }
          X[(wave * 64 + lane) * 2] = sr; X[(wave * 64 + lane) * 2 + 1] = si;
          float pr = ar, pi = ai;
#pragma unroll
          for (int j = 0; j < 7; ++j) { const float t0 = pr * pr - pi * pi, t1 = 2.0f * pr * pi; pr = t0; pi = t1; }
          __syncthreads();
          sr = 0.f; si = 0.f;
          for (int j = 0; j < wave; ++j) { const float lr = X[(j * 64 + lane) * 2], li = X[(j * 64 + lane) * 2 + 1]; const float nr = pr * sr - pi * si + lr, ni = pr * si + pi * sr + li; sr = nr; si = ni; }
#pragma unroll 16
          for (int k = 0; k < 128; ++k) { const size_t o = ((size_t)(k0 + k) * 32 + g) * 128 + lane; const float er = E[o], ei = E[o + 64]; Sb[o] = (bf16)f2bf(sr); Sb[o + 64] = (bf16)f2bf(si);
              const float nr = ar * sr - ai * si + er, ni = ar * si + ai * sr + ei; sr = nr; si = ni; }
          __syncthreads(); } }
    if (split) {
        if (blockIdx.x < 128) { const int e2 = blockIdx.x * 512 + tid, e = 2 * e2, h = e >> 15, d = e & 127; float S0 = 0.f, S1 = 0.f; const float* dp = dec + h * 128 + d; unsigned* sp = (unsigned*)ST + e2;
#pragma unroll 32
            for (int n = 0; n < NCH; ++n) { const unsigned u = sp[(size_t)n * 65536]; const float dc0 = dp[n * 512], dc1 = dp[n * 512 + 1]; sp[(size_t)n * 65536] = pk2(S0, S1); S0 = dc0 * S0 + blo(u); S1 = dc1 * S1 + bhi(u); } }
    } else {
        for (int e = blockIdx.x * 512 + tid; e < 131072; e += NGT) { const int h = e >> 15, d = e & 127; float S = 0.f; const float* dp = dec + h * 128 + d; bf16* sp = (bf16*)ST + e;
#pragma unroll 32
            for (int n = 0; n < NCH; ++n) { const float kv = bf2f(sp[(size_t)n * 131072]); const float dc = dp[n * 512]; sp[(size_t)n * 131072] = (bf16)f2bf(S); S = dc * S + kv; } }
    }
}
__device__ __forceinline__ void gla_phase_c(KArgs A, int l, const bf16* z, const float* ST, bf16* mixed, unsigned char* lds) {
    const int tid = tid_opaque(), lane = tid & 63, wave = __builtin_amdgcn_readfirstlane(tid >> 6), r = lane & 15, q = lane >> 4;
    bf16* sc = (bf16*)lds; float* red = (float*)(lds + 9216);
    const float* gnw = A->in[18] + l * 256;
    for (int unit = blockIdx.x; unit < 4 * NCH; unit += gridDim.x) { const int h = unit & 3, n = unit >> 2;
        const bf16* qbase = z + (size_t)(n * 64 + r) * LDZ + Z_Q + h * 128 + q * 8; const bf16* kbase = qbase + (Z_K - Z_Q);
        const int tm = wave & 3, vh = wave >> 2; const size_t tok = (size_t)(n * 64 + tm * 16 + r);
        bf16x8 vfr[2][8]; u32x2 rpre[8];
#pragma unroll
        for (int kk = 0; kk < 2; ++kk)
#pragma unroll
            for (int nt = 0; nt < 8; ++nt) vfr[kk][nt] = ld8(z + vt_off(n, h, vh * 128 + nt * 16 + r) + kk * 32 + q * 8);
#pragma unroll
        for (int nt = 0; nt < 8; ++nt) rpre[nt] = *(const u32x2*)(z + tok * LDZ + Z_R + h * 256 + vh * 128 + nt * 16 + 4 * q);
#pragma unroll
        for (int ti = 0; ti < 2; ++ti) { const int id = wave * 2 + ti, tm = id >> 2, tn = id & 3; f32x4 acc = (f32x4){0.f, 0.f, 0.f, 0.f};
            if (tn <= tm) {
#pragma unroll
                for (int kk = 0; kk < 4; ++kk) acc = mma(ld8(kbase + (size_t)(tn * 16) * LDZ + kk * 32), ld8(qbase + (size_t)(tm * 16) * LDZ + kk * 32), acc); }
            const int t = tm * 16 + r, s0 = tn * 16 + 4 * q; u32x2 w; w.x = pk2(s0 <= t ? acc[0] : 0.f, s0 + 1 <= t ? acc[1] : 0.f); w.y = pk2(s0 + 2 <= t ? acc[2] : 0.f, s0 + 3 <= t ? acc[3] : 0.f);
            *(u32x2*)(sc + t * 72 + s0) = w; }
        __syncthreads();
        f32x4 acc[8];
#pragma unroll
        for (int i = 0; i < 8; ++i) acc[i] = (f32x4){0.f, 0.f, 0.f, 0.f};
#pragma unroll
        for (int kk = 0; kk < 2; ++kk) { const bf16x8 a = ld8(sc + (tm * 16 + r) * 72 + kk * 32 + q * 8);
#pragma unroll
            for (int nt = 0; nt < 8; ++nt) acc[nt] = mma(vfr[kk][nt], a, acc[nt]); }
        const bf16* st = (const bf16*)ST + (size_t)(n * 4 + h) * 32768;
#pragma unroll
        for (int kk = 0; kk < 4; ++kk) { const bf16x8 a = ld8(qbase + (size_t)(tm * 16) * LDZ + kk * 32);
#pragma unroll
            for (int nt = 0; nt < 8; ++nt) acc[nt] = mma(ld8(st + (size_t)(vh * 128 + nt * 16 + r) * 128 + kk * 32 + q * 8), a, acc[nt]); }
        float ss = 0.f;
#pragma unroll
        for (int nt = 0; nt < 8; ++nt) ss += (acc[nt][0] * acc[nt][0] + acc[nt][1] * acc[nt][1]) + (acc[nt][2] * acc[nt][2] + acc[nt][3] * acc[nt][3]);
        ss += __shfl_xor(ss, 16); ss += __shfl_xor(ss, 32);
        if (q == 0) red[vh * 64 + tm * 16 + r] = ss;
        __syncthreads();
        const float rstd = rsqrtf((red[tm * 16 + r] + red[64 + tm * 16 + r]) * (1.0f / 256.0f) + EPS);
#pragma unroll
        for (int nt = 0; nt < 8; ++nt) { const int v = vh * 128 + nt * 16 + 4 * q; const f32x4 nw = *(const f32x4*)(gnw + v); const u32x2 rv = rpre[nt];
            const float r0 = blo(rv.x), r1 = bhi(rv.x), r2 = blo(rv.y), r3 = bhi(rv.y);
            const float o0 = acc[nt][0] * rstd * nw[0] * r0 * __builtin_amdgcn_rcpf(1.0f + __expf(-r0)), o1 = acc[nt][1] * rstd * nw[1] * r1 * __builtin_amdgcn_rcpf(1.0f + __expf(-r1)),
                        o2 = acc[nt][2] * rstd * nw[2] * r2 * __builtin_amdgcn_rcpf(1.0f + __expf(-r2)), o3 = acc[nt][3] * rstd * nw[3] * r3 * __builtin_amdgcn_rcpf(1.0f + __expf(-r3));
            u32x2 w; w.x = pk2(o0, o1); w.y = pk2(o2, o3); *(u32x2*)(mixed + tok * D + 1024 + h * 256 + v) = w; }
        __syncthreads();
    }
}
__device__ __forceinline__ void fixup_panel(const float* cw, const float* cb, const float* headg, const float* headv, const float* tailg, bf16* act, int pm, int tid) {
    constexpr int F4 = DFF / 4; const f32x4 zero = (f32x4){0.f, 0.f, 0.f, 0.f};
    for (int c = tid; c < F4; c += 512) { const int f = 4 * c;
        const f32x4 w0 = *(const f32x4*)(cw + f), w1 = *(const f32x4*)(cw + DFF + f), w2 = *(const f32x4*)(cw + 2 * DFF + f), bb = *(const f32x4*)(cb + f);
        f32x4 hg0[4], hg1[4], hv0[4], hv1[4], t0[4], t1[4];
#pragma unroll
        for (int gq = 0; gq < 4; ++gq) { const int G = pm * 4 + gq; const size_t h0 = ((size_t)G * 2) * DFF + f, h1 = h0 + DFF;
            hg0[gq] = *(const f32x4*)(headg + h0); hg1[gq] = *(const f32x4*)(headg + h1); hv0[gq] = *(const f32x4*)(headv + h0); hv1[gq] = *(const f32x4*)(headv + h1);
            t0[gq] = G > 0 ? *(const f32x4*)(tailg + ((size_t)(G - 1) * 2) * DFF + f) : zero; t1[gq] = G > 0 ? *(const f32x4*)(tailg + ((size_t)(G - 1) * 2 + 1) * DFF + f) : zero; }
#pragma unroll
        for (int gq = 0; gq < 4; ++gq) { const int G = pm * 4 + gq;
            const f32x4 ga = bb + w0 * t0[gq] + w1 * t1[gq] + w2 * hg0[gq], gb = bb + w0 * t1[gq] + w1 * hg0[gq] + w2 * hg1[gq]; float a[4], b[4];
#pragma unroll
            for (int j = 0; j < 4; ++j) { a[j] = ga[j] * __builtin_amdgcn_rcpf(1.0f + __expf(-ga[j])) * hv0[gq][j]; b[j] = gb[j] * __builtin_amdgcn_rcpf(1.0f + __expf(-gb[j])) * hv1[gq][j]; }
            u32x2 wa; wa.x = pk2(a[0], a[1]); wa.y = pk2(a[2], a[3]); *(u32x2*)(act + (size_t)(G * 64) * DFF + f) = wa;
            u32x2 wb; wb.x = pk2(b[0], b[1]); wb.y = pk2(b[2], b[3]); *(u32x2*)(act + (size_t)(G * 64 + 1) * DFF + f) = wb; }
    }
}
__device__ __forceinline__ void final_phase(float* out, const float* sq, const float* fw, int gw, int NGW, int lane) {
    f32x4 w[8];
#pragma unroll
    for (int j = 0; j < 8; ++j) w[j] = *((const f32x4*)fw + lane + 64 * j);
    for (int m = gw; m < M; m += 2 * NGW) { const int m2 = (m + NGW < M) ? m + NGW : m; f32x4* xr = (f32x4*)(out + (size_t)m * D) + lane; f32x4* xr2 = (f32x4*)(out + (size_t)m2 * D) + lane;
        const float rs = rsqrtf(sq[m] * (1.0f / D) + EPS), rs2 = rsqrtf(sq[m2] * (1.0f / D) + EPS); f32x4 v[8], v2[8];
#pragma unroll
        for (int j = 0; j < 8; ++j) { v[j] = xr[64 * j]; v2[j] = xr2[64 * j]; }
#pragma unroll
        for (int j = 0; j < 8; ++j) { xr[64 * j] = v[j] * rs * w[j]; if (m2 != m) xr2[64 * j] = v2[j] * rs2 * w[j]; } }
}
#define LAS __attribute__((address_space(3)))
#define XB_TMO      128
#define XB_XCNT(j)  (256  + 64 * (j))
#define XB_XSUB(j)  (1280 + 64 * (j))
#define XB_XGEN(j)  (2304 + 64 * (j))
#define XB_TOP      3328
#define XB_TOPGEN   3392
#define XCD_BAR_WORDS 3456
#define XB_SPIN_CAP (1u << 18)

__device__ __forceinline__ unsigned xb_ld(unsigned* p)              { return __hip_atomic_load(p, __ATOMIC_RELAXED, __HIP_MEMORY_SCOPE_AGENT); }
__device__ __forceinline__ unsigned xb_add(unsigned* p, unsigned v) { return __hip_atomic_fetch_add(p, v, __ATOMIC_RELAXED, __HIP_MEMORY_SCOPE_AGENT); }
__device__ __forceinline__ unsigned xb_xcc_id() { return (unsigned)__builtin_amdgcn_s_getreg((3 << 11) | 20) & 0xFu; }
#define XB_SPIN(cond, bar) do { unsigned _sp = 0; while (cond) { __builtin_amdgcn_s_sleep(1); \
    if ((++_sp & 255u) == 0u) { if (xb_ld(&(bar)[XB_TMO])) break; if (_sp > XB_SPIN_CAP) { atomicAdd(&(bar)[XB_TMO], 1u); break; } } } } while (0)

struct XcdBarrier {
    unsigned* bar; unsigned x;
    volatile LAS unsigned* st;
};

__device__ __forceinline__ XcdBarrier xcd_barrier_post(unsigned* bar, volatile LAS unsigned* st) {
    XcdBarrier b; b.bar = bar; b.x = xb_xcc_id(); b.st = st;
    if (threadIdx.x == 0) (void)xb_add(&bar[XB_XCNT(b.x)], 1u);
    return b;
}
__device__ __forceinline__ void xcd_barrier_complete(unsigned* bar, unsigned x, unsigned& nloc, unsigned& nx) {
    const unsigned G = gridDim.x * gridDim.y * gridDim.z;
    unsigned sum, cnt, mine, sp = 0u;
    for (;;) {
        sum = 0u; cnt = 0u; mine = 0u;
#pragma unroll
        for (unsigned j = 0; j < 16; ++j) { const unsigned c = xb_ld(&bar[XB_XCNT(j)]); sum += c; cnt += (c > 0u) ? 1u : 0u; mine = (j == x) ? c : mine; }
        if (sum == G) break;
        __builtin_amdgcn_s_sleep(1);
        if ((++sp & 255u) == 0u) { if (xb_ld(&bar[XB_TMO])) break; if (sp > XB_SPIN_CAP) { atomicAdd(&bar[XB_TMO], 1u); break; } }
    }
    nloc = mine > 0u ? mine : 1u; nx = cnt > 0u ? cnt : 1u;
}

__device__ __forceinline__ void xcd_barrier(const XcdBarrier& b) {
    asm volatile("s_waitcnt vmcnt(0)" ::: "memory");
    __syncthreads();
    if (threadIdx.x == 0) {
        unsigned* bar = b.bar;
        __builtin_amdgcn_s_waitcnt(0);
        unsigned nloc = b.st[0], nx = b.st[1];
        if (nloc == 0u) { xcd_barrier_complete(bar, b.x, nloc, nx); b.st[0] = nloc; b.st[1] = nx; }
        const unsigned old = xb_add(&bar[XB_XSUB(b.x)], 1u);
        const unsigned gen = old / nloc;
        if (old + 1u == (gen + 1u) * nloc) {
            __builtin_amdgcn_fence(__ATOMIC_RELEASE, "agent");
            asm volatile("s_waitcnt vmcnt(0)" ::: "memory");
            (void)xb_add(&bar[XB_TOP], 1u);
        }
        XB_SPIN(xb_ld(&bar[XB_TOP]) < (gen + 1u) * nx, bar);
        __builtin_amdgcn_fence(__ATOMIC_ACQUIRE, "agent");
        asm volatile("s_waitcnt vmcnt(0)" ::: "memory");
    }
    __syncthreads();
}

struct FixedOrder : pg8::StaticOrder { __host__ __device__ bool next(int i, pg8::Unit& u) const { const bool ok = pg8::StaticOrder::next(i, u); u.pm = 0; u.pn = 0; return ok; } };
template <int PH, bool REP = false> __device__ __forceinline__ void run_phase(unsigned char* lds) {
    pg8::PG8_LAS_T ldsl = (pg8::PG8_LAS_T)lds;
    const int tid = tid_opaque(), lane = tid & 63, wave = __builtin_amdgcn_readfirstlane(tid >> 6);
    const int G = gridDim.x, gw = blockIdx.x * 8 + wave, NGW = G * 8;
    KArgs A = (KArgs)__builtin_amdgcn_kernarg_segment_ptr(); asm volatile("" : "+s"(A));
    unsigned char* ws = A->ws; asm volatile("" : "+s"(ws));
    float* sq = (float*)(ws + WS_SQ); bf16* mixed = (bf16*)(ws + WS_MIX); bf16* z = (bf16*)(ws + WS_Z);
    float* ST = (float*)(ws + WS_ST); float* E = (float*)(ws + WS_E); bf16* Sb = (bf16*)(ws + WS_SB); bf16* ybuf = (bf16*)(ws + WS_Y); float* dec = (float*)(ws + WS_DEC);
    bf16* act = (bf16*)(ws + WS_ACT); float* headg = (float*)(ws + WS_HEADG); float* headv = (float*)(ws + WS_HEADV); float* tailg = (float*)(ws + WS_TAILG);
    if constexpr (PH == 0) { if (EN(10)) phase_prologue(A, lds); }
    else if constexpr (PH == NPHASE - 1) { if (EN(11)) final_phase(A->out, sq + 6 * M, A->in[28], gw, NGW, lane); }
    else {
        constexpr int l = (PH - 1) / 9, sp = (PH - 1) % 9; unsigned char* wl = ws + WS_L0 + (size_t)l * WS_LSTRIDE;
        const float* sq_mix = sq + (size_t)(3 * l) * M; float* sq_ffn = sq + (size_t)(3 * l + 1) * M; float* sq_ple = sq + (size_t)(3 * l + 2) * M; float* sq_nxt = sq + (size_t)(3 * l + 3) * M;
        bf16* hb_cur = (bf16*)(ws + (l == 0 ? WS_HB : WS_HB2)); bf16* hb_alt = (bf16*)(ws + (l == 0 ? WS_HB2 : WS_HB));
        pg8::StaticOrder S;
        if constexpr (sp == 0) { if (EN(0)) { pg8::Gemm g{hb_cur, (const bf16*)(wl + L_WIN), M, NZ, D}; S.init(M, NZ, G, (int)blockIdx.x); pg8::EpiScaleBf16 Ep{z, LDZ, sq_mix, 1.0f / D};
                  pg8::gemm_phase<pg8::EpiScaleBf16, pg8::StaticOrder, true, true>(ldsl, g, S, Ep);
                  glr_phase(wl, hb_cur, sq_mix, (float*)(ws + WS_GLR), gw, NGW, lane); } }
        else if constexpr (sp == 1) { constexpr int sub = REP ? REPSUB : SUB; if (EN(1)) { if (sub & 1) s5_phase_a(wl, z, E, gw, NGW, lane); if ((sub & 4) && !REP) gla_phase_a(A, l, z, (const float*)(ws + WS_GLR), ST, dec, lds); } }
        else if constexpr (sp == 2) { if (EN(2)) { scan_phase(wl, ST, dec, E, Sb, lds); pool_phase(wl, z, A->in[15] + l * 512, mixed, (unsigned*)(ws + WS_CNT) + 64 * l, lane); } }
        else if constexpr (sp == 3) { constexpr int sub = REP ? REPSUB : SUB; if (EN(3)) { if (sub & 1) s5_phase_c(wl, z, Sb, A->in[11] + l * 512, ybuf, lds); if (sub & 2) gla_phase_c(A, l, z, ST, mixed, lds); } }
        else if constexpr (sp == 4) { if (EN(4)) { pg8::Gemm g{ybuf, (const bf16*)(wl + L_WGLU), M, 512, 512}; S.init(M, 512, G, (int)blockIdx.x); pg8::EpiGlu Ep{ybuf, A->in[13] + l * 512, mixed};
                  pg8::gemm_phase<pg8::EpiGlu, pg8::StaticOrder, true, true>(ldsl, g, S, Ep); } }
        else if constexpr (sp == 5) { if (EN(5)) { pg8::Gemm g{mixed, (const bf16*)(wl + L_WOUT), M, D, D}; S.init(M, D, G, (int)blockIdx.x); pg8::EpiRes Ep{l == 0 ? A->in[0] : A->out, A->out, hb_alt, sq_ffn};
                  pg8::gemm_phase<pg8::EpiRes, pg8::StaticOrder, true, true>(ldsl, g, S, Ep); } }
        else if constexpr (sp == 6) { if (EN(6)) { pg8::Gemm g{hb_alt, (const bf16*)(wl + L_WUP), M, NUP, D}; S.init(M, NUP, G, (int)blockIdx.x);
#ifdef PROBE_NULL_EPI
                  if constexpr (REP) { pg8::EpiNull En;
#ifdef PROBE_FIXED_TILE
                      FixedOrder SF; SF.init(M, NUP, G, (int)blockIdx.x); pg8::gemm_phase<pg8::EpiNull, FixedOrder, true, true>(ldsl, g, SF, En);
#else
                      pg8::gemm_phase<pg8::EpiNull, pg8::StaticOrder, true, true>(ldsl, g, S, En);
#endif
                  } else
#endif
                  {
                  pg8::EpiUp Ep{act, sq_ffn, A->in[22] + (size_t)l * 3 * DFF, A->in[23] + l * DFF, headg, headv, tailg};
                  pg8::gemm_phase<pg8::EpiUp, pg8::StaticOrder, true, true>(ldsl, g, S, Ep); } } }
        else if constexpr (sp == 7) { if (EN(7)) {
                  { int Kp = PLED; asm volatile("" : "+s"(Kp)); pg8::Gemm g{(const bf16*)(ws + WS_PB) + (size_t)l * M * PLED, (const bf16*)(wl + L_WPLE), M, D, Kp}; S.init(M, D, G, (int)blockIdx.x); pg8::EpiScaleBf16 Ep{mixed, D, nullptr, 0.f};
                    pg8::gemm_phase<pg8::EpiScaleBf16, pg8::StaticOrder, true, true>(ldsl, g, S, Ep); }
                  S.init(M, D, G, (int)blockIdx.x);
                  { pg8::Unit u; int last = -1; for (int i = 0; S.next(i, u); ++i) { if (u.pm != last) fixup_panel(A->in[22] + (size_t)l * 3 * DFF, A->in[23] + l * DFF, headg, headv, tailg, act, u.pm, tid); last = u.pm; } }
                  asm volatile("s_waitcnt vmcnt(0)" ::: "memory"); __syncthreads();
                  { pg8::Gemm g{act, (const bf16*)(wl + L_WDN), M, D, DFF}; pg8::EpiRes Ep{A->out, A->out, hb_cur, sq_ple};
                    pg8::gemm_phase<pg8::EpiRes, pg8::StaticOrder, true, true>(ldsl, g, S, Ep); } } }
        else { if (EN(8)) { pg8::Gemm g{hb_cur, (const bf16*)(wl + L_WPG), M, D, D}; S.init(M, D, G, (int)blockIdx.x); pg8::EpiPg Ep{A->out, A->out, hb_alt, sq_nxt, sq_ple, mixed};
                  pg8::gemm_phase<pg8::EpiPg, pg8::StaticOrder, true, true>(ldsl, g, S, Ep); } }
    }
}
__global__ void __launch_bounds__(512, 2) hymba_fwd(Args args) {
    extern __shared__ __attribute__((aligned(16))) unsigned char lds[];
    const int lo = args.ph_lo, hi = args.ph_hi;
    volatile LAS unsigned* misc = (volatile LAS unsigned*)((LAS unsigned char*)lds + (LDS_BYTES - 64));
    if (threadIdx.x < 16) misc[threadIdx.x] = 0u;
    __syncthreads();
    const XcdBarrier bar = xcd_barrier_post((unsigned*)(args.ws + WS_BAR), misc);
    if (hi > 1000) cg::this_grid().sync();
#ifndef REPEAT_MASK
#define REPEAT_MASK 0
#endif
#define REPBIT(k) ((k) == 0 ? 10 : ((k) == NPHASE - 1 ? 11 : ((k) - 1) % 9))
#define RUN(k) if (lo <= (k) && (k) < hi) { if ((k) != lo) xcd_barrier(bar); run_phase<(k)>(lds); if ((REPEAT_MASK >> REPBIT(k)) & 1) { xcd_barrier(bar); run_phase<(k), true>(lds); } }
    RUN(0) RUN(1) RUN(2) RUN(3) RUN(4) RUN(5) RUN(6) RUN(7) RUN(8) RUN(9) RUN(10)
    RUN(11) RUN(12) RUN(13) RUN(14) RUN(15) RUN(16) RUN(17) RUN(18) RUN(19)
#undef RUN
}

#ifndef N_LAUNCH_MODE
#define N_LAUNCH_MODE 0
#endif
extern "C" void kernel_launch(void* const* d_in, const int* in_sizes, int n_in, void* d_out, int out_size, void* d_ws, size_t ws_size, hipStream_t stream) {
    static int grid = 0;
    if (grid == 0) {
        if (n_in != 29 || out_size != M * D || ws_size < WS_END) { fprintf(stderr, "kernel_launch: unexpected shapes (n_in %d out %d ws %zu need %zu)\n", n_in, out_size, ws_size, (size_t)WS_END); grid = -1; return; }
        int dev = 0, cus = 0, per_cu = 0;
        if (hipGetDevice(&dev) != hipSuccess || hipDeviceGetAttribute(&cus, hipDeviceAttributeMultiprocessorCount, dev) != hipSuccess) { grid = -1; return; }
        if (hipFuncSetAttribute((const void*)hymba_fwd, hipFuncAttributeMaxDynamicSharedMemorySize, LDS_BYTES) != hipSuccess) { fprintf(stderr, "kernel_launch: hipFuncSetAttribute failed\n"); grid = -1; return; }
        if (hipOccupancyMaxActiveBlocksPerMultiprocessor(&per_cu, (const void*)hymba_fwd, 512, LDS_BYTES) != hipSuccess || per_cu < 1) { fprintf(stderr, "kernel_launch: occupancy query says %d\n", per_cu); per_cu = 1; }
        (void)hipGetLastError();
        grid = cus * per_cu;
    }
    if (grid < 0) return;
    if (hipMemsetAsync((char*)d_ws + WS_BAR, 0, 16384 + 1024, stream) != hipSuccess) { fprintf(stderr, "kernel_launch: memset failed\n"); return; }
    Args a{};
    for (int i = 0; i < 29; ++i) a.in[i] = (const float*)d_in[i];
    a.out = (float*)d_out; a.ws = (unsigned char*)d_ws;
#if N_LAUNCH_MODE == 1
    for (int ph = 0; ph < NPHASE; ++ph) { a.ph_lo = ph; a.ph_hi = ph + 1; hipLaunchKernelGGL(hymba_fwd, dim3(grid), dim3(512), LDS_BYTES, stream, a); }
#else
    a.ph_lo = 0; a.ph_hi = NPHASE;
    void* kargs[] = {&a};
    hipError_t e = hipLaunchCooperativeKernel((const void*)hymba_fwd, dim3(grid), dim3(512), kargs, LDS_BYTES, stream);
    if (e != hipSuccess) fprintf(stderr, "kernel_launch: cooperative launch failed: %s (grid %d)\n", hipGetErrorString(e), grid);
#endif
}
```

```cpp
#include <hip/hip_runtime.h>
#include <hip/hip_cooperative_groups.h>
#include <cstdio>
#include <cstdint>
namespace cg = cooperative_groups;
namespace pg8 {
#define PG8_LAS __attribute__((address_space(3)))
typedef unsigned short bf16_t;
typedef short bf16x8 __attribute__((ext_vector_type(8)));
typedef float f32x4 __attribute__((ext_vector_type(4)));
typedef unsigned u32x4 __attribute__((ext_vector_type(4)));
constexpr int BM = 256, BK = 64, HALF = 128, HTB = HALF * BK * 2  , STAGE_BYTES = 8 * HTB, NXCD = 8, WGM = 8;

__host__ __device__ __forceinline__ int lds_byte(int r, int c) { const int st = (r >> 4) * 2 + (c >> 5), rr = r & 15, cc = c & 31, ob = rr * 64 + cc * 2; return st * 1024 + (ob ^ (((ob >> 9) & 1) << 5)); }
__host__ __device__ __forceinline__ void stage_rc(int b, int& R, int& C) { const int st = b / 1024, sb = b % 1024, swz = sb ^ (((sb >> 9) & 1) << 5); R = (st >> 1) * 16 + swz / 64; C = (st & 1) * 32 + (swz % 64) / 2; }
__host__ __device__ __forceinline__ int perm32(int rho) { const int n = rho >> 4, i = rho & 15; return 8 * (i >> 2) + 4 * n + (i & 3); }

struct Unit { int pm, pn; };
struct Gemm { const bf16_t* A; const bf16_t* Bt; int M, N, K; };

struct StaticOrder {
    int nM, nN, nwg, G, c;
    __host__ __device__ void init(int M, int N, int G_, int c_) { nM = M / BM; nN = N / BM; nwg = nM * nN; G = G_; c = c_; }
    __host__ __device__ bool next(int i, Unit& u) const {
        const long L = (long)i * G + c; if (L >= nwg) return false;
        int wgid = (int)L; { const int q = nwg / NXCD, r = nwg % NXCD, xcd = wgid % NXCD, off = wgid / NXCD; wgid = (xcd < r ? xcd * (q + 1) : r * (q + 1) + (xcd - r) * q) + off; }
        const int nig = WGM * nN, gid = wgid / nig, fm = gid * WGM, gsz = (nM - fm) < WGM ? (nM - fm) : WGM;
        u.pm = fm + ((wgid % nig) % gsz); u.pn = (wgid % nig) / gsz; return true;
    }
    __device__ __forceinline__ void a_ready(const Unit&) const {}
    __device__ __forceinline__ void done(const Unit&) const {}
};
typedef PG8_LAS unsigned char* PG8_LAS_T;

__device__ __forceinline__ unsigned cvt_pk_bf16(float lo, float hi) { unsigned r; asm volatile("v_cvt_pk_bf16_f32 %0, %1, %2" : "=v"(r) : "v"(lo), "v"(hi)); return r; }
typedef unsigned u32x2 __attribute__((ext_vector_type(2)));
constexpr float RMS_EPS = 1e-6f;
constexpr int DM = 2048, DFF = 5632;
__device__ __forceinline__ float sigm(float x) { return __builtin_amdgcn_rcpf(1.0f + __expf(-x)); }
__device__ __forceinline__ float bflo(unsigned u) { return __uint_as_float(u << 16); }
__device__ __forceinline__ float bfhi(unsigned u) { return __uint_as_float(u & 0xffff0000u); }

struct EpiScaleBf16 {
    static constexpr bool PERM = true, AFTER_DRAIN = false;
    bf16_t* O; int ldc; const float* rowsq; float inv_n;
    __device__ __forceinline__ void operator()(const f32x4 (&acc)[2][2][4][2], const Unit& u, int wr, int wc, int fr, int fq) const {
        const int row0 = u.pm * BM + wr * 64 + fr, col0 = u.pn * BM + wc * 32 + 8 * fq;
        float rq[2][4];
#pragma unroll
        for (int ai = 0; ai < 2; ++ai)
#pragma unroll
            for (int m = 0; m < 4; ++m) rq[ai][m] = rowsq ? rowsq[row0 + ai * HALF + m * 16] : 0.f;
#pragma unroll
        for (int ai = 0; ai < 2; ++ai)
#pragma unroll
            for (int m = 0; m < 4; ++m) { const int row = row0 + ai * HALF + m * 16; const float rs = rowsq ? rsqrtf(rq[ai][m] * inv_n + RMS_EPS) : 1.0f;
                bf16_t* rowp = O + (size_t)row * ldc + col0;
#pragma unroll
                for (int bj = 0; bj < 2; ++bj) { const f32x4 v0 = acc[ai][bj][m][0] * rs, v1 = acc[ai][bj][m][1] * rs;
                    u32x4 w; w.x = cvt_pk_bf16(v0[0], v0[1]); w.y = cvt_pk_bf16(v0[2], v0[3]); w.z = cvt_pk_bf16(v1[0], v1[1]); w.w = cvt_pk_bf16(v1[2], v1[3]);
                    *(u32x4*)(rowp + bj * HALF) = w; } }
    }
};

struct EpiRes {
    static constexpr bool PERM = false, AFTER_DRAIN = false;
    const float* base; float* out; bf16_t* hb; float* sq_next;
    __device__ __forceinline__ void operator()(const f32x4 (&acc)[2][2][4][2], const Unit& u, int wr, int wc, int fr, int fq) const {
        const int row0 = u.pm * BM + wr * 64 + fr, col0 = u.pn * BM + wc * 32 + 4 * fq;
#pragma unroll
        for (int ai = 0; ai < 2; ++ai) {
            f32x4 bs[4][2][2];
#pragma unroll
            for (int m = 0; m < 4; ++m)
#pragma unroll
                for (int bj = 0; bj < 2; ++bj)
#pragma unroll
                    for (int n = 0; n < 2; ++n) bs[m][bj][n] = *(const f32x4*)(base + (size_t)(row0 + ai * HALF + m * 16) * DM + col0 + bj * HALF + n * 16);
#pragma unroll
            for (int m = 0; m < 4; ++m) { const int row = row0 + ai * HALF + m * 16; const size_t off = (size_t)row * DM + col0; float ss = 0.f;
#pragma unroll
                for (int bj = 0; bj < 2; ++bj)
#pragma unroll
                    for (int n = 0; n < 2; ++n) { const size_t o2 = off + bj * HALF + n * 16; const f32x4 o = bs[m][bj][n] + acc[ai][bj][m][n];
                        *(f32x4*)(out + o2) = o; u32x2 w; w.x = cvt_pk_bf16(o[0], o[1]); w.y = cvt_pk_bf16(o[2], o[3]); *(u32x2*)(hb + o2) = w;
                        ss += (o[0] * o[0] + o[1] * o[1]) + (o[2] * o[2] + o[3] * o[3]); }
                ss += __shfl_xor(ss, 16); ss += __shfl_xor(ss, 32);
                if (fq == 0) unsafeAtomicAdd(sq_next + row, ss); }
            asm volatile("" ::: "memory"); }
    }
};

struct EpiPg {
    static constexpr bool PERM = false, AFTER_DRAIN = false;
    const float* base; float* out; bf16_t* hb; float* sq_next; const float* rowsq; const bf16_t* ple;
    __device__ __forceinline__ void operator()(const f32x4 (&acc)[2][2][4][2], const Unit& u, int wr, int wc, int fr, int fq) const {
        const int row0 = u.pm * BM + wr * 64 + fr, col0 = u.pn * BM + wc * 32 + 4 * fq;
#pragma unroll
        for (int ai = 0; ai < 2; ++ai)
#pragma unroll
            for (int mh = 0; mh < 2; ++mh) {
                f32x4 bs[2][2][2]; u32x2 pl[2][2][2]; float rs[2];
#pragma unroll
                for (int mm = 0; mm < 2; ++mm) { const int row = row0 + ai * HALF + (mh * 2 + mm) * 16; rs[mm] = rowsq[row];
#pragma unroll
                    for (int bj = 0; bj < 2; ++bj)
#pragma unroll
                        for (int n = 0; n < 2; ++n) { const size_t o2 = (size_t)row * DM + col0 + bj * HALF + n * 16; bs[mm][bj][n] = *(const f32x4*)(base + o2); pl[mm][bj][n] = *(const u32x2*)(ple + o2); } }
#pragma unroll
                for (int mm = 0; mm < 2; ++mm) { const int m = mh * 2 + mm; const int row = row0 + ai * HALF + m * 16; const size_t off = (size_t)row * DM + col0; float ss = 0.f;
                    const float r = rsqrtf(rs[mm] * (1.0f / DM) + RMS_EPS);
#pragma unroll
                    for (int bj = 0; bj < 2; ++bj)
#pragma unroll
                        for (int n = 0; n < 2; ++n) { const size_t o2 = off + bj * HALF + n * 16; const f32x4 b = bs[mm][bj][n]; const u32x2 p = pl[mm][bj][n];
                            const f32x4 a = acc[ai][bj][m][n] * r; f32x4 o;
                            o[0] = b[0] + bflo(p.x) * sigm(a[0]); o[1] = b[1] + bfhi(p.x) * sigm(a[1]); o[2] = b[2] + bflo(p.y) * sigm(a[2]); o[3] = b[3] + bfhi(p.y) * sigm(a[3]);
                            *(f32x4*)(out + o2) = o; u32x2 w; w.x = cvt_pk_bf16(o[0], o[1]); w.y = cvt_pk_bf16(o[2], o[3]); *(u32x2*)(hb + o2) = w;
                            ss += (o[0] * o[0] + o[1] * o[1]) + (o[2] * o[2] + o[3] * o[3]); }
                    ss += __shfl_xor(ss, 16); ss += __shfl_xor(ss, 32);
                    if (fq == 0) unsafeAtomicAdd(sq_next + row, ss); }
                asm volatile("" ::: "memory"); }
    }
};

struct EpiGlu {
    static constexpr bool PERM = true, AFTER_DRAIN = false;
    const bf16_t* ybuf; const float* bias; bf16_t* O;
    __device__ __forceinline__ void operator()(const f32x4 (&acc)[2][2][4][2], const Unit& u, int wr, int wc, int fr, int fq) const {
        const int row0 = u.pm * BM + wr * 64 + fr, col0 = u.pn * BM + wc * 32 + 8 * fq;
#pragma unroll
        for (int ai = 0; ai < 2; ++ai)
#pragma unroll
            for (int m = 0; m < 4; ++m) { const int row = row0 + ai * HALF + m * 16;
#pragma unroll
                for (int bj = 0; bj < 2; ++bj) { const int c = col0 + bj * HALF; const u32x4 yv = *(const u32x4*)(ybuf + (size_t)row * 512 + c);
                    const f32x4 b0 = *(const f32x4*)(bias + c), b1 = *(const f32x4*)(bias + c + 4); const f32x4 a0 = acc[ai][bj][m][0] + b0, a1 = acc[ai][bj][m][1] + b1;
                    u32x4 w; w.x = cvt_pk_bf16(bflo(yv.x) * sigm(a0[0]), bfhi(yv.x) * sigm(a0[1])); w.y = cvt_pk_bf16(bflo(yv.y) * sigm(a0[2]), bfhi(yv.y) * sigm(a0[3]));
                    w.z = cvt_pk_bf16(bflo(yv.z) * sigm(a1[0]), bfhi(yv.z) * sigm(a1[1])); w.w = cvt_pk_bf16(bflo(yv.w) * sigm(a1[2]), bfhi(yv.w) * sigm(a1[3]));
                    *(u32x4*)(O + (size_t)row * DM + c) = w; } }
    }
};

struct EpiUp {
    static constexpr bool PERM = true, AFTER_DRAIN = false;
    bf16_t* act; const float* rowsq; const float* cw; const float* cb; float* headg; float* headv; float* tailg;
    __device__ __forceinline__ void operator()(const f32x4 (&acc)[2][2][4][2], const Unit& u, int wr, int wc, int fr, int fq) const {
        const int row0 = u.pm * BM + wr * 64 + fr, f00 = u.pn * HALF + wc * 32 + 8 * fq;
        const int lane = (int)(threadIdx.x & 63); const int src1 = (lane & 48) | ((fr + 15) & 15), src2 = (lane & 48) | ((fr + 14) & 15);
        float rq[2][4]; f32x4 cwv[2][4];
#pragma unroll
        for (int ai = 0; ai < 2; ++ai)
#pragma unroll
            for (int m = 0; m < 4; ++m) rq[ai][m] = rowsq[row0 + ai * HALF + m * 16];
#pragma unroll
        for (int n = 0; n < 2; ++n) { const int f0 = f00 + 4 * n; cwv[n][0] = *(const f32x4*)(cw + f0); cwv[n][1] = *(const f32x4*)(cw + DFF + f0); cwv[n][2] = *(const f32x4*)(cw + 2 * DFF + f0); cwv[n][3] = *(const f32x4*)(cb + f0); }
#pragma unroll
        for (int ai = 0; ai < 2; ++ai) {
            float rs[4];
#pragma unroll
            for (int m = 0; m < 4; ++m) rs[m] = rsqrtf(rq[ai][m] * (1.0f / DM) + RMS_EPS);
            const int G = u.pm * 4 + ai * 2 + wr;
#pragma unroll
            for (int n = 0; n < 2; ++n) { const int f0 = f00 + 4 * n;
                const f32x4 w0 = cwv[n][0], w1 = cwv[n][1], w2 = cwv[n][2], bb = cwv[n][3];
                f32x4 r1p = (f32x4){0.f, 0.f, 0.f, 0.f}, r2p = r1p;
#pragma unroll
                for (int m = 0; m < 4; ++m) { const int row = row0 + ai * HALF + m * 16;
                    const f32x4 g = acc[ai][0][m][n] * rs[m], v = acc[ai][1][m][n] * rs[m]; f32x4 r1, r2;
#pragma unroll
                    for (int j = 0; j < 4; ++j) { r1[j] = __shfl(g[j], src1); r2[j] = __shfl(g[j], src2); }
                    f32x4 p1, p2;
#pragma unroll
                    for (int j = 0; j < 4; ++j) { p1[j] = fr >= 1 ? r1[j] : r1p[j]; p2[j] = fr >= 2 ? r2[j] : r2p[j]; }
                    if (m == 0 && fr < 2) { *(f32x4*)(headg + ((size_t)G * 2 + fr) * DFF + f0) = g; *(f32x4*)(headv + ((size_t)G * 2 + fr) * DFF + f0) = v; }
                    else { f32x4 gc = bb + w0 * p2 + w1 * p1 + w2 * g; f32x4 a;
#pragma unroll
                        for (int j = 0; j < 4; ++j) a[j] = gc[j] * sigm(gc[j]) * v[j];
                        u32x2 w; w.x = cvt_pk_bf16(a[0], a[1]); w.y = cvt_pk_bf16(a[2], a[3]); *(u32x2*)(act + (size_t)row * DFF + f0) = w; }
                    if (m == 3 && fr >= 14) *(f32x4*)(tailg + ((size_t)G * 2 + (fr - 14)) * DFF + f0) = g;
                    r1p = r1; r2p = r2; }
            }
        }
    }
};

struct EpiNull {
    static constexpr bool PERM = true, AFTER_DRAIN = false;
    __device__ __forceinline__ void operator()(const f32x4 (&acc)[2][2][4][2], const Unit& u, int wr, int wc, int fr, int fq) const {
#pragma unroll
        for (int ai = 0; ai < 2; ++ai)
#pragma unroll
            for (int bj = 0; bj < 2; ++bj)
#pragma unroll
                for (int m = 0; m < 4; ++m)
#pragma unroll
                    for (int n = 0; n < 2; ++n) asm volatile("" :: "v"(acc[ai][bj][m][n]));
    }
};

template <class Epi, class Sched, bool ALIGN_EPI = false, bool SP2 = false>
__device__ __forceinline__ void gemm_phase(PG8_LAS unsigned char* lds, const Gemm g, const Sched& S, const Epi& E) {
    int tid_l = threadIdx.x; asm volatile("" : "+v"(tid_l)); const int tid = tid_l, wid = __builtin_amdgcn_readfirstlane(tid >> 6), lane = tid & 63, wr = wid >> 2, wc = wid & 3, fr = lane & 15, fq = lane >> 4;
    const int K = g.K, nt = K / BK;
    unsigned voffA[2], voffB[2];
#pragma unroll
    for (int i = 0; i < 2; ++i) { int R, C; stage_rc(tid * 16 + i * 8192, R, C); const int Rb = Epi::PERM ? ((R & ~31) + perm32(R & 31)) : R;
        voffA[i] = (unsigned)(R * K + C) * 2u; voffB[i] = (unsigned)(Rb * K + C) * 2u; }
    const size_t kstep = (size_t)(BK * 2);
    const size_t hstep = (size_t)HALF * K * 2;
    const size_t tstep = 2 * hstep;
    const unsigned ldsw = (unsigned)wid * 1024u;
    const int aoff = lds_byte(wr * 64 + fr, fq * 8), boff = lds_byte(wc * 32 + fr, fq * 8);
#define PG8_SA(b, h) (((b) * 2 + (h)) * HTB)
#define PG8_SB(b, h) ((4 + (b) * 2 + (h)) * HTB)
#define PG8_STAGE(bufoff, gbase, voff) do { _Pragma("unroll") for (int _i = 0; _i < 2; ++_i) \
        __builtin_amdgcn_global_load_lds((const unsigned*)((const char*)(gbase) + (voff)[_i]), (PG8_LAS unsigned*)(lds + (bufoff) + ldsw + _i * 8192), 16, 0, 0); } while (0)
#define PG8_LDA(dst, b, h) do { _Pragma("unroll") for (int m = 0; m < 4; ++m) _Pragma("unroll") for (int k = 0; k < 2; ++k) dst[m][k] = *(const PG8_LAS bf16x8*)(lds + PG8_SA(b, h) + aoff + m * 2048 + k * 1024); } while (0)
#define PG8_LDB(dst, b, h) do { _Pragma("unroll") for (int n = 0; n < 2; ++n) _Pragma("unroll") for (int k = 0; k < 2; ++k) dst[n][k] = *(const PG8_LAS bf16x8*)(lds + PG8_SB(b, h) + boff + n * 2048 + k * 1024); } while (0)
#define PG8_MMA(ai, bj, At, Bt) do { __builtin_amdgcn_s_setprio(1); _Pragma("unroll") for (int m = 0; m < 4; ++m) _Pragma("unroll") for (int n = 0; n < 2; ++n) _Pragma("unroll") for (int k = 0; k < 2; ++k) \
        acc[ai][bj][m][n] = __builtin_amdgcn_mfma_f32_16x16x32_bf16(Bt[n][k], At[m][k], acc[ai][bj][m][n], 0, 0, 0); __builtin_amdgcn_s_setprio(0); } while (0)
#define PG8_WAIT_V(n) asm volatile("s_waitcnt vmcnt(" #n ")" ::: "memory")
#define PG8_WAIT_L(n) asm volatile("s_waitcnt lgkmcnt(" #n ")" ::: "memory")
#define PG8_BAR __builtin_amdgcn_s_barrier()
#define PG8_SCHED __builtin_amdgcn_sched_barrier(0)
    Unit cur, nxt; int ui = 0;
    if (!S.next(0, cur)) return;
    f32x4 acc[2][2][4][2];
#pragma unroll
    for (int a = 0; a < 2; ++a)
#pragma unroll
        for (int b = 0; b < 2; ++b)
#pragma unroll
            for (int m = 0; m < 4; ++m)
#pragma unroll
                for (int n = 0; n < 2; ++n) acc[a][b][m][n] = (f32x4){0.f, 0.f, 0.f, 0.f};
    bf16x8 At[4][2], B0[2][2], B1[2][2];
    const char* cA = (const char*)g.A + (size_t)cur.pm * tstep; const char* cB = (const char*)g.Bt + (size_t)cur.pn * tstep;
    S.a_ready(cur);
    if constexpr (SP2) {
        PG8_STAGE(PG8_SB(0, 0), cB, voffB); PG8_STAGE(PG8_SB(0, 1), cB + hstep, voffB); PG8_STAGE(PG8_SA(0, 0), cA, voffA); PG8_STAGE(PG8_SA(0, 1), cA + hstep, voffA);
        if (wr == 1) PG8_BAR;
        PG8_WAIT_V(2); PG8_BAR;
        PG8_STAGE(PG8_SB(1, 0), cB + kstep, voffB); PG8_STAGE(PG8_SA(1, 0), cA + kstep, voffA); PG8_STAGE(PG8_SB(1, 1), cB + hstep + kstep, voffB);
        PG8_WAIT_V(6); PG8_BAR;
    } else {
        PG8_STAGE(PG8_SB(0, 0), cB, voffB); PG8_STAGE(PG8_SA(0, 0), cA, voffA); PG8_STAGE(PG8_SB(0, 1), cB + hstep, voffB); PG8_STAGE(PG8_SA(0, 1), cA + hstep, voffA);
        if (wr == 1) PG8_BAR;
        PG8_WAIT_V(4); PG8_BAR;
        PG8_STAGE(PG8_SB(1, 0), cB + kstep, voffB); PG8_STAGE(PG8_SA(1, 0), cA + kstep, voffA); PG8_STAGE(PG8_SB(1, 1), cB + hstep + kstep, voffB);
        PG8_WAIT_V(6); PG8_BAR;
    }
    for (;;) {
        const bool has_next = S.next(ui + 1, nxt);
        const char* nA = has_next ? (const char*)g.A + (size_t)nxt.pm * tstep : cA; const char* nB = has_next ? (const char*)g.Bt + (size_t)nxt.pn * tstep : cB;
        for (int t = 0; t < nt; t += 2) {
            const bool last = (t == nt - 2);
            const char* a1 = cA + (size_t)(t + 1) * kstep;
            const char* a2 = last ? nA : cA + (size_t)(t + 2) * kstep; const char* b2 = last ? nB : cB + (size_t)(t + 2) * kstep;
            const char* a3 = a2 + kstep; const char* b3 = b2 + kstep;
            if (last && has_next) S.a_ready(nxt);
            if constexpr (SP2) {
            PG8_LDB(B0, 0, 0); PG8_LDB(B1, 0, 1); PG8_SCHED; PG8_LDA(At, 0, 0); PG8_STAGE(PG8_SA(1, 1), a1 + hstep, voffA);
            PG8_WAIT_V(8); PG8_WAIT_L(0); PG8_BAR; PG8_MMA(0, 0, At, B0); PG8_MMA(0, 1, At, B1); PG8_BAR; PG8_SCHED;
            PG8_LDA(At, 0, 1); PG8_STAGE(PG8_SB(0, 0), b2, voffB); PG8_STAGE(PG8_SB(0, 1), b2 + hstep, voffB); PG8_STAGE(PG8_SA(0, 0), a2, voffA);
            PG8_WAIT_V(8); PG8_WAIT_L(0); PG8_BAR; PG8_MMA(1, 0, At, B0); PG8_MMA(1, 1, At, B1); PG8_BAR; PG8_SCHED;
            PG8_LDB(B0, 1, 0); PG8_LDB(B1, 1, 1); PG8_SCHED; PG8_LDA(At, 1, 0); PG8_STAGE(PG8_SA(0, 1), a2 + hstep, voffA);
            PG8_WAIT_V(8); PG8_WAIT_L(0); PG8_BAR; PG8_MMA(0, 0, At, B0); PG8_MMA(0, 1, At, B1); PG8_BAR; PG8_SCHED;
            PG8_LDA(At, 1, 1); PG8_STAGE(PG8_SB(1, 0), b3, voffB); PG8_STAGE(PG8_SB(1, 1), b3 + hstep, voffB); PG8_STAGE(PG8_SA(1, 0), a3, voffA);
            PG8_WAIT_V(8); PG8_WAIT_L(0); PG8_BAR; PG8_MMA(1, 0, At, B0); PG8_MMA(1, 1, At, B1); PG8_BAR; PG8_SCHED;
            } else {
            PG8_LDB(B0, 0, 0); PG8_SCHED; PG8_LDA(At, 0, 0); PG8_STAGE(PG8_SA(1, 1), a1 + hstep, voffA);
            PG8_WAIT_L(8); PG8_BAR; PG8_WAIT_L(0); PG8_MMA(0, 0, At, B0); PG8_BAR; PG8_SCHED;
            PG8_LDB(B1, 0, 1); PG8_STAGE(PG8_SB(0, 0), b2, voffB);
            PG8_BAR; PG8_WAIT_L(0); PG8_MMA(0, 1, At, B1); PG8_BAR;
            PG8_LDA(At, 0, 1); PG8_STAGE(PG8_SA(0, 0), a2, voffA);
            PG8_BAR; PG8_WAIT_L(0); PG8_MMA(1, 0, At, B0); PG8_BAR; PG8_SCHED;
            PG8_STAGE(PG8_SB(0, 1), b2 + hstep, voffB);
            PG8_WAIT_V(6); PG8_BAR; PG8_MMA(1, 1, At, B1); PG8_BAR;
            PG8_LDB(B0, 1, 0); PG8_SCHED; PG8_LDA(At, 1, 0); PG8_STAGE(PG8_SA(0, 1), a2 + hstep, voffA);
            PG8_WAIT_L(8); PG8_BAR; PG8_WAIT_L(0); PG8_MMA(0, 0, At, B0); PG8_BAR; PG8_SCHED;
            PG8_LDB(B1, 1, 1); PG8_STAGE(PG8_SB(1, 0), b3, voffB);
            PG8_BAR; PG8_WAIT_L(0); PG8_MMA(0, 1, At, B1); PG8_BAR;
            PG8_LDA(At, 1, 1); PG8_STAGE(PG8_SA(1, 0), a3, voffA);
            PG8_BAR; PG8_WAIT_L(0); PG8_MMA(1, 0, At, B0); PG8_BAR; PG8_SCHED;
            PG8_STAGE(PG8_SB(1, 1), b3 + hstep, voffB);
            PG8_WAIT_V(6); PG8_BAR; PG8_MMA(1, 1, At, B1); PG8_BAR;
            }
        }
        if constexpr (ALIGN_EPI) { if (wr == 0) PG8_BAR; }
        if constexpr (!Epi::AFTER_DRAIN) { E(acc, cur, wr, wc, fr, fq); S.done(cur); }
        if (!has_next) break;
#pragma unroll
        for (int a = 0; a < 2; ++a)
#pragma unroll
            for (int b = 0; b < 2; ++b)
#pragma unroll
                for (int m = 0; m < 4; ++m)
#pragma unroll
                    for (int n = 0; n < 2; ++n) acc[a][b][m][n] = (f32x4){0.f, 0.f, 0.f, 0.f};
        cur = nxt; cA = nA; cB = nB; ++ui;
        if constexpr (ALIGN_EPI) { if (wr == 1) PG8_BAR; }
    }
    PG8_WAIT_V(0);
    if constexpr (!ALIGN_EPI) { if (wr == 0) PG8_BAR; }
    PG8_BAR;
    if constexpr (Epi::AFTER_DRAIN) { E.fused(acc, cur, wr, wc, fr, fq, lds, wid, lane); S.done(cur); }
#undef PG8_SA
#undef PG8_SB
#undef PG8_STAGE
#undef PG8_LDA
#undef PG8_LDB
#undef PG8_MMA
#undef PG8_WAIT_V
#undef PG8_WAIT_L
#undef PG8_BAR
#undef PG8_SCHED
}
}

typedef unsigned short bf16;
typedef short bf16x8 __attribute__((ext_vector_type(8)));
typedef float f32x4 __attribute__((ext_vector_type(4)));
typedef unsigned u32x4 __attribute__((ext_vector_type(4)));
typedef unsigned u32x2 __attribute__((ext_vector_type(2)));
constexpr int M = 16384, D = 2048, NIN = 4112, LDZ = 4096, DFF = 5632, NUP = 11264, PLED = 256;
constexpr int Z_POOL = 512, Z_Q = 1024, Z_K = 1536, Z_V = 2048, Z_R = 3072;
constexpr int NCH = 256;
constexpr int S5T = 16, S5NC = 1024;
constexpr float EPS = 1e-6f;
constexpr size_t MiB = 1u << 20;
constexpr size_t WS_SQ = 0, WS_BAR = 512 * 1024, WS_CNT = WS_BAR + 16384;
constexpr size_t WS_L0 = 1 * MiB, WS_LSTRIDE = 110 * MiB;
constexpr size_t L_WIN = 0, L_WG = 16 * MiB, L_WOUT = 17 * MiB, L_WUP = 25 * MiB, L_WDN = 69 * MiB, L_WPG = 91 * MiB, L_WPLE = 99 * MiB, L_WGLU = 100 * MiB, L_POOLW = 100 * MiB + 512 * 1024,
                 L_PT = 101 * MiB, L_QT = 103 * MiB, L_BT = 105 * MiB, L_A16 = 109 * MiB;
constexpr size_t WS_HB = 221 * MiB, WS_PB = 285 * MiB, WS_MIX = 301 * MiB, WS_R1 = 365 * MiB;
constexpr size_t WS_Z = WS_R1, WS_ST = WS_R1 + 136 * MiB, WS_E = WS_ST + 128 * MiB, WS_SB = WS_E + 16 * MiB, WS_Y = WS_SB + 8 * MiB, WS_DEC = WS_Y + 16 * MiB;
constexpr size_t WS_ACT = WS_R1, WS_HEADG = WS_R1 + 176 * MiB, WS_HEADV = WS_HEADG + 11 * MiB, WS_TAILG = WS_HEADV + 11 * MiB;
constexpr size_t WS_HB2 = WS_R1 + 209 * MiB;
constexpr size_t WS_GLR = WS_DEC + 1 * MiB;
constexpr size_t WS_END = WS_GLR + 1 * MiB;
constexpr int LDS_BYTES = 147456;
constexpr int NPHASE = 20;
#ifndef PHASE_MASK
#define PHASE_MASK 0xFFF
#endif
#define EN(x) ((PHASE_MASK >> (x)) & 1)
#ifndef SUB
#define SUB 7
#endif
#ifndef REPSUB
#define REPSUB 7
#endif

__device__ __forceinline__ unsigned f2bf(float f) { unsigned u = __float_as_uint(f); return (u + 0x7fffu + ((u >> 16) & 1u)) >> 16; }
__device__ __forceinline__ unsigned pk2(float lo, float hi) { return f2bf(lo) | (f2bf(hi) << 16); }
__device__ __forceinline__ float bf2f(bf16 b) { return __uint_as_float(((unsigned)b) << 16); }
__device__ __forceinline__ float blo(unsigned u) { return __uint_as_float(u << 16); }
__device__ __forceinline__ float bhi(unsigned u) { return __uint_as_float(u & 0xffff0000u); }
__device__ __forceinline__ bf16x8 ld8(const bf16* p) { return *(const bf16x8*)p; }
__device__ __forceinline__ f32x4 mma(bf16x8 b, bf16x8 a, f32x4 c) { return __builtin_amdgcn_mfma_f32_16x16x32_bf16(b, a, c, 0, 0, 0); }
__device__ __forceinline__ float wave_sum(float v) {
#pragma unroll
    for (int o = 1; o < 64; o <<= 1) v += __shfl_xor(v, o);
    return v;
}
__device__ __forceinline__ float gelu_tanh(float x) { const float y = 0.7978845608f * (x + 0.044715f * x * x * x); const float e = __expf(2.0f * y); return x * (1.0f - __builtin_amdgcn_rcpf(e + 1.0f)); }

__device__ __forceinline__ int tid_opaque() { int t = threadIdx.x; asm volatile("" : "+v"(t)); return t; }
struct Args { const float* in[29]; float* out; unsigned char* ws; int ph_lo, ph_hi; };
typedef const __attribute__((address_space(4))) Args* KArgs;

__device__ __forceinline__ void transpose_item(const float* W, int ldw, int nvalid, const float* kscale, bf16* WT, int ldt, int drow0, int k0, int n0, float* scr, int lane) {
    const int nn = n0 + lane; const bool ok = nn < nvalid; const float* wp = W + (size_t)k0 * ldw + nn;
    float tv[64];
#pragma unroll
    for (int kk = 0; kk < 64; ++kk) tv[kk] = ok ? wp[(size_t)kk * ldw] : 0.f;
#pragma unroll
    for (int kk = 0; kk < 64; ++kk) { float v = tv[kk]; if (kscale) v *= kscale[k0 + kk]; scr[kk * 65 + lane] = v; }
    asm volatile("s_waitcnt lgkmcnt(0)" ::: "memory");
    const int c = lane & 7;
#pragma unroll
    for (int j = 0; j < 8; ++j) { const int n = (lane >> 3) + 8 * j; const float* sp = scr + (8 * c) * 65 + n;
        u32x4 o; o.x = pk2(sp[0 * 65], sp[1 * 65]); o.y = pk2(sp[2 * 65], sp[3 * 65]); o.z = pk2(sp[4 * 65], sp[5 * 65]); o.w = pk2(sp[6 * 65], sp[7 * 65]);
        *(u32x4*)(WT + (size_t)(drow0 + n) * ldt + k0 + 8 * c) = o; }
    asm volatile("s_waitcnt lgkmcnt(0)" ::: "memory");
}

__device__ __forceinline__ void s5_precompute(KArgs A, int l, int g, unsigned char* wl, float* L) {
    const int tid = tid_opaque(); const int lg = l * 32 + g;
    float* powr = L; float* powi = L + 1088; float* Bbr = L + 2176; float* Bbi = L + 3200; float* Cr = L + 4224; float* Ci = L + 5248; float* Km = L + 6272;
    const float* a_re = A->in[4] + lg * 64; const float* a_im = A->in[5] + lg * 64;
    const double dt = (double)expf(A->in[6][lg]);
    for (int idx = tid; idx < 17 * 64; idx += 512) { const int d = idx >> 6, n = idx & 63;
        const double ang = (double)a_im[n] * dt * d, mag = exp((double)a_re[n] * dt * d); powr[idx] = (float)(mag * cos(ang)); powi[idx] = (float)(mag * sin(ang)); }
    for (int idx = tid; idx < 1024; idx += 512) { const int n = idx >> 4, c = idx & 15;
        const double are = a_re[n], aim = a_im[n], zr = are * dt, zi = aim * dt, e = exp(zr), er = e * cos(zi) - 1.0, ei = e * sin(zi), den = are * are + aim * aim;
        const double fr = (er * are + ei * aim) / den, fi = (ei * are - er * aim) / den;
        const double br = A->in[7][(size_t)(lg * 64 + n) * 16 + c], bi = A->in[8][(size_t)(lg * 64 + n) * 16 + c];
        Bbr[idx] = (float)(fr * br - fi * bi); Bbi[idx] = (float)(fr * bi + fi * br); }
    for (int idx = tid; idx < 1024; idx += 512) { Cr[idx] = A->in[9][(size_t)lg * 1024 + idx]; Ci[idx] = A->in[10][(size_t)lg * 1024 + idx]; }
    __syncthreads();
    for (int idx = tid; idx < 4096; idx += 512) { const int d = idx >> 8, cp = (idx >> 4) & 15, c = idx & 15; float s = 0.f;
        for (int n = 0; n < 64; ++n) { const float cr = Cr[cp * 64 + n], ci = Ci[cp * 64 + n], pr = powr[d * 64 + n], pi = powi[d * 64 + n];
            const float wr = cr * pr - ci * pi, wi = cr * pi + ci * pr; s += wr * Bbr[n * 16 + c] - wi * Bbi[n * 16 + c]; }
        Km[idx] = s; }
    __syncthreads();
    bf16* Pt = (bf16*)(wl + L_PT) + (size_t)g * 128 * 256; bf16* QT = (bf16*)(wl + L_QT) + (size_t)g * 256 * 128; bf16* BT = (bf16*)(wl + L_BT) + (size_t)g * 256 * 256; float* A16 = (float*)(wl + L_A16) + g * 128;
    for (int idx = tid; idx < 32768; idx += 512) { const int np = idx >> 8, j = idx & 255, s = j >> 4, c = j & 15, n = np & 63;
        const float pr = powr[(15 - s) * 64 + n], pi = powi[(15 - s) * 64 + n], br = Bbr[n * 16 + c], bi = Bbi[n * 16 + c];
        Pt[idx] = (bf16)f2bf(np < 64 ? (pr * br - pi * bi) : (pr * bi + pi * br)); }
    for (int idx = tid; idx < 32768; idx += 512) { const int nn = idx >> 7, np = idx & 127, t = nn >> 4, cp = nn & 15, n = np & 63;
        const float pr = powr[(t + 1) * 64 + n], pi = powi[(t + 1) * 64 + n], cr = Cr[cp * 64 + n], ci = Ci[cp * 64 + n];
        QT[idx] = (bf16)f2bf(np < 64 ? (cr * pr - ci * pi) : -(cr * pi + ci * pr)); }
    for (int idx = tid; idx < 65536; idx += 512) { const int nn = idx >> 8, j = idx & 255, t = nn >> 4, cp = nn & 15, s = j >> 4, c = j & 15;
        BT[idx] = (bf16)f2bf(s <= t ? Km[(t - s) * 256 + cp * 16 + c] : 0.f); }
    if (tid < 64) { A16[tid * 2] = powr[16 * 64 + tid]; A16[tid * 2 + 1] = powi[16 * 64 + tid]; }
    __syncthreads();
}

__device__ __forceinline__ void phase_prologue(KArgs A, unsigned char* lds) {
    const int tid = tid_opaque(), lane = tid & 63, wave = __builtin_amdgcn_readfirstlane(tid >> 6);
    const int G = gridDim.x, gw = blockIdx.x * 8 + wave, NGW = G * 8, gt = blockIdx.x * 512 + tid, NGT = G * 512;
    unsigned char* ws = A->ws;
    for (int it = blockIdx.x; it < 64; it += G) s5_precompute(A, it >> 5, it & 31, ws + WS_L0 + (size_t)(it >> 5) * WS_LSTRIDE, (float*)lds);
    const bool skip64 = G >= 128; const int NGW2 = skip64 ? (G - 64) * 8 : NGW, NGT2 = skip64 ? (G - 64) * 512 : NGT;
    const int gw2 = skip64 ? ((int)blockIdx.x >= 64 ? gw - 512 : M) : gw, gt2 = skip64 ? ((int)blockIdx.x >= 64 ? gt - 64 * 512 : 2 * M * PLED) : gt;
    { float* sq = (float*)(ws + WS_SQ); for (int i = gt; i < 6 * M; i += NGT) sq[M + i] = 0.f; }
    { const f32x4* p4 = (const f32x4*)A->in[1]; u32x2* o = (u32x2*)(ws + WS_PB);
#pragma unroll 8
      for (int i = gt2; i < 2 * M * PLED / 4; i += NGT2) { const f32x4 v = p4[i]; u32x2 w; w.x = pk2(v[0], v[1]); w.y = pk2(v[2], v[3]); o[i] = w; } }
    { float* sq = (float*)(ws + WS_SQ); bf16* hb = (bf16*)(ws + WS_HB);
      for (int m = gw2; m < M; m += 2 * NGW2) { const int m2 = (m + NGW2 < M) ? m + NGW2 : m;
          const f32x4* xr = (const f32x4*)(A->in[0] + (size_t)m * D) + lane; const f32x4* xr2 = (const f32x4*)(A->in[0] + (size_t)m2 * D) + lane; f32x4 v[8], v2[8];
#pragma unroll
          for (int j = 0; j < 8; ++j) { v[j] = xr[64 * j]; v2[j] = xr2[64 * j]; }
          u32x2* o = (u32x2*)(hb + (size_t)m * D) + lane; u32x2* o2 = (u32x2*)(hb + (size_t)m2 * D) + lane; float s = 0.f, s2 = 0.f;
#pragma unroll
          for (int j = 0; j < 8; ++j) { s += (v[j][0] * v[j][0] + v[j][1] * v[j][1]) + (v[j][2] * v[j][2] + v[j][3] * v[j][3]); u32x2 w; w.x = pk2(v[j][0], v[j][1]); w.y = pk2(v[j][2], v[j][3]); o[64 * j] = w;
              s2 += (v2[j][0] * v2[j][0] + v2[j][1] * v2[j][1]) + (v2[j][2] * v2[j][2] + v2[j][3] * v2[j][3]); u32x2 w2; w2.x = pk2(v2[j][0], v2[j][1]); w2.y = pk2(v2[j][2], v2[j][3]); o2[64 * j] = w2; }
          s = wave_sum(s); s2 = wave_sum(s2); if (lane == 0) { sq[m] = s; sq[m2] = s2; } } }
    float* scr = (float*)(lds + wave * 16640);
    constexpr int I_IN = 32 * 65, I_OUT = 32 * 32, I_UP = 32 * 176, I_DN = 88 * 32, I_PG = 32 * 32, I_PLE = 4 * 32, I_GLU = 8 * 8, I_POOL = 16;
    constexpr int I_LAYER = I_IN + I_OUT + I_UP + I_DN + I_PG + I_PLE + I_GLU + I_POOL;
    for (int it = gw; it < 2 * I_LAYER; it += NGW) {
        const int l = it >= I_LAYER ? 1 : 0; int r = it - l * I_LAYER; unsigned char* wl = ws + WS_L0 + (size_t)l * WS_LSTRIDE;
        if (r < I_IN) { const int kb = r / 65, nb = r % 65; const float* W = A->in[3] + (size_t)l * D * NIN; const float* ks = A->in[2] + l * D;
            if (nb < 48) transpose_item(W, NIN, NIN, ks, (bf16*)(wl + L_WIN), D, 64 * nb, 64 * kb, 64 * nb, scr, lane);
            else if (nb == 48) transpose_item(W, NIN, 3088, ks, (bf16*)(wl + L_WG), D, 0, 64 * kb, 3072, scr, lane);
            else transpose_item(W, NIN, NIN, ks, (bf16*)(wl + L_WIN), D, 3072 + 64 * (nb - 49), 64 * kb, 3088 + 64 * (nb - 49), scr, lane);
            continue; } r -= I_IN;
        if (r < I_OUT) { const int kb = r / 32, nb = r % 32; transpose_item(A->in[19] + (size_t)l * D * D, D, D, nullptr, (bf16*)(wl + L_WOUT), D, 64 * nb, 64 * kb, 64 * nb, scr, lane); continue; } r -= I_OUT;
        if (r < I_UP) { const int kb = r / 176, nb = r % 176, n0 = 64 * nb, isv = n0 >= DFF ? 1 : 0, f = n0 - isv * DFF, drow = (f >> 7) * 256 + isv * 128 + (f & 127);
            transpose_item(A->in[21] + (size_t)l * D * NUP, NUP, NUP, A->in[20] + l * D, (bf16*)(wl + L_WUP), D, drow, 64 * kb, n0, scr, lane); continue; } r -= I_UP;
        if (r < I_DN) { const int kb = r / 32, nb = r % 32; transpose_item(A->in[24] + (size_t)l * DFF * D, D, D, nullptr, (bf16*)(wl + L_WDN), DFF, 64 * nb, 64 * kb, 64 * nb, scr, lane); continue; } r -= I_DN;
        if (r < I_PG) { const int kb = r / 32, nb = r % 32; transpose_item(A->in[27] + (size_t)l * D * D, D, D, A->in[25] + l * D, (bf16*)(wl + L_WPG), D, 64 * nb, 64 * kb, 64 * nb, scr, lane); continue; } r -= I_PG;
        if (r < I_PLE) { const int kb = r / 32, nb = r % 32; transpose_item(A->in[26] + (size_t)l * PLED * D, D, D, nullptr, (bf16*)(wl + L_WPLE), PLED, 64 * nb, 64 * kb, 64 * nb, scr, lane); continue; } r -= I_PLE;
        if (r < I_GLU) { const int kb = r / 8, nb = r % 8; transpose_item(A->in[12] + (size_t)l * 512 * 512, 512, 512, nullptr, (bf16*)(wl + L_WGLU), 512, 64 * nb, 64 * kb, 64 * nb, scr, lane); continue; } r -= I_GLU;
        { const int gi = r >> 2, kb = (r >> 1) & 1, nb = r & 1; transpose_item(A->in[14] + (size_t)(l * 4 + gi) * 128 * 128, 128, 128, nullptr, (bf16*)(wl + L_POOLW) + gi * 128 * 128, 128, 64 * nb, 64 * kb, 64 * nb, scr, lane); }
    }
}

__device__ __forceinline__ void glr_phase(const unsigned char* wl, const bf16* hb, const float* rowsq, float* glr, int gw, int NGW, int lane) {
    const int r = lane & 15, q = lane >> 4; const bf16* WG = (const bf16*)(wl + L_WG);
    for (int task = gw; task < M / 16; task += NGW) { const int t = task * 16 + r; f32x4 acc = (f32x4){0.f, 0.f, 0.f, 0.f};
        const bf16* arow = hb + (size_t)t * D + q * 8; const bf16* brow = WG + (size_t)r * D + q * 8;
#pragma unroll 16
        for (int kk = 0; kk < D / 32; ++kk) acc = mma(ld8(brow + kk * 32), ld8(arow + kk * 32), acc);
        const float rs = rsqrtf(rowsq[t] * (1.0f / D) + EPS);
        *(f32x4*)(glr + (size_t)t * 16 + 4 * q) = acc * rs; }
}

__device__ __forceinline__ void s5_phase_a(const unsigned char* wl, const bf16* z, float* E, unsigned char* lds) {
    const int tid = tid_opaque(), lane = tid & 63, wave = __builtin_amdgcn_readfirstlane(tid >> 6), r = lane & 15, q = lane >> 4;
    const bf16* Pt = (const bf16*)(wl + L_PT); bf16* Bs = (bf16*)lds;
    for (int tb = blockIdx.x; tb < 256; tb += gridDim.x) { const int g = tb & 31, mb = (tb >> 5) * 8 + wave, k = mb * 16 + r;
        f32x4 acc[8];
#pragma unroll
        for (int i = 0; i < 8; ++i) acc[i] = (f32x4){0.f, 0.f, 0.f, 0.f};
        const bf16* arow = z + (size_t)(k * 16) * LDZ + g * 16 + (size_t)(q >> 1) * LDZ + (q & 1) * 8;
        const int nn0 = tid >> 2, part = tid & 3; const bf16* p0 = Pt + (size_t)(g * 128 + nn0) * 256 + part * 8;
        u32x4 pb = *(const u32x4*)p0; bf16x8 pa = ld8(arow);
#pragma unroll 1
        for (int kk = 0; kk < 8; ++kk) { bf16* buf = Bs + (kk & 1) * (128 * 40);
            *(u32x4*)(buf + nn0 * 40 + part * 8) = pb; const bf16x8 a = pa;
            __syncthreads();
            if (kk + 1 < 8) { pb = *(const u32x4*)(p0 + (kk + 1) * 32); pa = ld8(arow + (size_t)(2 * (kk + 1)) * LDZ); }
#pragma unroll
            for (int nt = 0; nt < 8; ++nt) acc[nt] = mma(ld8(buf + (nt * 16 + r) * 40 + q * 8), a, acc[nt]);
        }
#pragma unroll
        for (int nt = 0; nt < 8; ++nt) *(f32x4*)(E + ((size_t)k * 32 + g) * 128 + nt * 16 + 4 * q) = acc[nt];
        __syncthreads();
    }
}
__device__ __forceinline__ void s5_phase_c(const unsigned char* wl, const bf16* z, const bf16* Sb, const float* dskip, bf16* ybuf, unsigned char* lds) {
    const int tid = tid_opaque(), lane = tid & 63, wave = __builtin_amdgcn_readfirstlane(tid >> 6), r = lane & 15, q = lane >> 4;
    const bf16* QT = (const bf16*)(wl + L_QT); const bf16* BT = (const bf16*)(wl + L_BT); bf16* Bs = (bf16*)lds;
    for (int tb = blockIdx.x; tb < 256; tb += gridDim.x) { const int g = tb & 31, mb = (tb >> 5) * 8 + wave, k = mb * 16 + r;
        f32x4 acc[16];
#pragma unroll
        for (int i = 0; i < 16; ++i) acc[i] = (f32x4){0.f, 0.f, 0.f, 0.f};
        const bf16* srow = Sb + ((size_t)k * 32 + g) * 128 + q * 8; const bf16* arow = z + (size_t)(k * 16) * LDZ + g * 16 + (size_t)(q >> 1) * LDZ + (q & 1) * 8;
        const int nn0 = tid >> 2, part = tid & 3;
        const bf16* q0 = QT + (size_t)(g * 256 + nn0) * 128 + part * 8; const bf16* b0 = BT + (size_t)(g * 256 + nn0) * 256 + part * 8;
        u32x4 pb0 = *(const u32x4*)q0, pb1 = *(const u32x4*)(q0 + (size_t)128 * 128); bf16x8 pa = ld8(srow);
#pragma unroll 1
        for (int kk = 0; kk < 12; ++kk) { bf16* buf = Bs + (kk & 1) * (256 * 40);
            *(u32x4*)(buf + nn0 * 40 + part * 8) = pb0; *(u32x4*)(buf + (nn0 + 128) * 40 + part * 8) = pb1; const bf16x8 a = pa;
            __syncthreads();
            if (kk + 1 < 12) { const int k1 = kk + 1;
                if (k1 < 4) { pb0 = *(const u32x4*)(q0 + k1 * 32); pb1 = *(const u32x4*)(q0 + (size_t)128 * 128 + k1 * 32); pa = ld8(srow + k1 * 32); }
                else { pb0 = *(const u32x4*)(b0 + (k1 - 4) * 32); pb1 = *(const u32x4*)(b0 + (size_t)128 * 256 + (k1 - 4) * 32); pa = ld8(arow + (size_t)(2 * (k1 - 4)) * LDZ); } }
            const int smin = kk < 4 ? 0 : 2 * (kk - 4);
#pragma unroll
            for (int nt = 0; nt < 16; ++nt) if (nt >= smin) acc[nt] = mma(ld8(buf + (nt * 16 + r) * 40 + q * 8), a, acc[nt]);
        }
        const f32x4 dsk = *(const f32x4*)(dskip + g * 16 + 4 * q);
#pragma unroll
        for (int nt = 0; nt < 16; ++nt) { const size_t tok = (size_t)k * 16 + nt; const u32x2 uv = *(const u32x2*)(z + tok * LDZ + g * 16 + 4 * q);
            const float y0 = gelu_tanh(acc[nt][0] + dsk[0] * blo(uv.x)), y1 = gelu_tanh(acc[nt][1] + dsk[1] * bhi(uv.x)), y2 = gelu_tanh(acc[nt][2] + dsk[2] * blo(uv.y)), y3 = gelu_tanh(acc[nt][3] + dsk[3] * bhi(uv.y));
            u32x2 w; w.x = pk2(y0, y1); w.y = pk2(y2, y3); *(u32x2*)(ybuf + tok * 512 + g * 16 + 4 * q) = w; }
        __syncthreads();
    }
}
__device__ __forceinline__ void pool_phase(const unsigned char* wl, const bf16* z, const float* pscale, bf16* mixed, unsigned* ctr, int lane) {
    const int r = lane & 15, q = lane >> 4; const bf16* PW = (const bf16*)(wl + L_POOLW);
    for (;;) { unsigned tk = 0u; if (lane == 0) tk = __hip_atomic_fetch_add(ctr, 1u, __ATOMIC_RELAXED, __HIP_MEMORY_SCOPE_AGENT); const int task = __builtin_amdgcn_readfirstlane((int)tk); if (task >= 4096) break; { const int gi = (task >> 3) & 3, tb = (task >> 5) * 8 + (task & 7), t = tb * 16 + r, w = 2 << gi; const int cnt = (t + 1) < w ? (t + 1) : w; const float inv = 1.0f / (float)cnt;
        f32x4 acc[8];
#pragma unroll
        for (int i = 0; i < 8; ++i) acc[i] = (f32x4){0.f, 0.f, 0.f, 0.f};
#pragma unroll 2
        for (int kk = 0; kk < 4; ++kk) { const bf16* zp = z + (size_t)t * LDZ + Z_POOL + gi * 128 + kk * 32 + q * 8;
            float s[8]; const u32x4 cur = *(const u32x4*)zp; float c0[8] = {blo(cur.x), bhi(cur.x), blo(cur.y), bhi(cur.y), blo(cur.z), bhi(cur.z), blo(cur.w), bhi(cur.w)};
#pragma unroll
            for (int j = 0; j < 8; ++j) s[j] = c0[j];
#pragma unroll
            for (int i = 1; i < 16; ++i) { if (i < w && t - i >= 0) { const u32x4 v = *(const u32x4*)(zp - (size_t)i * LDZ);
                s[0] += blo(v.x); s[1] += bhi(v.x); s[2] += blo(v.y); s[3] += bhi(v.y); s[4] += blo(v.z); s[5] += bhi(v.z); s[6] += blo(v.w); s[7] += bhi(v.w); } }
            u32x4 pa; pa.x = pk2(s[0] * inv - c0[0], s[1] * inv - c0[1]); pa.y = pk2(s[2] * inv - c0[2], s[3] * inv - c0[3]); pa.z = pk2(s[4] * inv - c0[4], s[5] * inv - c0[5]); pa.w = pk2(s[6] * inv - c0[6], s[7] * inv - c0[7]);
            const bf16x8 a = __builtin_bit_cast(bf16x8, pa);
#pragma unroll
            for (int nt = 0; nt < 8; ++nt) acc[nt] = mma(ld8(PW + (size_t)(gi * 128 + nt * 16 + r) * 128 + kk * 32 + q * 8), a, acc[nt]); }
#pragma unroll
        for (int nt = 0; nt < 8; ++nt) { const int dcol = gi * 128 + nt * 16 + 4 * q; const f32x4 sc = *(const f32x4*)(pscale + dcol); const f32x4 o = acc[nt] * sc;
            u32x2 wv; wv.x = pk2(o[0], o[1]); wv.y = pk2(o[2], o[3]); *(u32x2*)(mixed + (size_t)t * D + 512 + dcol) = wv; }
    } }
}
__device__ __forceinline__ void gla_gates(const float* ba, int h, unsigned char* lds, int tid) {
    float* bL = (float*)lds; float* glr = (float*)(lds + 32768); float* wa = (float*)(lds + 36864); float* part = (float*)(lds + 45056);
    { const int d = tid & 127; const float bias = ba[h * 128 + d]; float w[16];
#pragma unroll
      for (int rr = 0; rr < 16; ++rr) w[rr] = wa[rr * 128 + d];
#pragma unroll 4
      for (int j = 0; j < 16; ++j) { const int t = (tid >> 7) + 4 * j; float lg = bias;
#pragma unroll
          for (int rr = 0; rr < 16; ++rr) lg += glr[t * 16 + rr] * w[rr];
          const float ls = fminf(lg, 0.f) - __logf(1.0f + __expf(-fabsf(lg))); bL[t * 128 + d] = ls * (1.0f / 16.0f); } }
    __syncthreads();
    { const int seg = tid >> 7, d = tid & 127; float a = 0.f;
#pragma unroll
      for (int t = 0; t < 16; ++t) { a += bL[(seg * 16 + t) * 128 + d]; bL[(seg * 16 + t) * 128 + d] = a; }
      part[seg * 128 + d] = a; }
    __syncthreads();
    { const int seg = tid >> 7, d = tid & 127; float off = 0.f;
      for (int s2 = 0; s2 < seg; ++s2) off += part[s2 * 128 + d];
      if (seg > 0) {
#pragma unroll
          for (int t = 0; t < 16; ++t) bL[(seg * 16 + t) * 128 + d] += off; } }
    __syncthreads();
}
__device__ __forceinline__ size_t vt_off(int n, int h, int v) { return (size_t)(n * 64 + (v >> 2)) * LDZ + Z_V + 256 * h + 64 * (v & 3); }
__device__ __forceinline__ void gla_phase_a(KArgs A, int l, bf16* z, const float* glrg, float* ST, float* dec, unsigned char* lds) {
    const int tid = tid_opaque(), lane = tid & 63, wave = __builtin_amdgcn_readfirstlane(tid >> 6), r = lane & 15, q = lane >> 4;
    float* bL = (float*)lds; bf16* k2T = (bf16*)(lds + 47104); bf16* vT = (bf16*)(lds + 65536);
    const float* wa2 = A->in[16] + (size_t)l * 16 * 512; float* glrL = (float*)(lds + 32768); float* waL = (float*)(lds + 36864);
    u32x4 vpre[4], qpre[2], kpre[2], nv[4], nq[2], nk[2]; float cg[2], cw[4], ng[2], nw4[4];
#define GLA_LOAD(U, Q, K, V, GG, WW) do { const int h_ = (U) & 3, n_ = (U) >> 2; \
        _Pragma("unroll") for (int j = 0; j < 2; ++j) { const int i = tid + j * 512, t = i >> 4, d0 = (i & 15) * 8; const bf16* qp_ = z + (size_t)(n_ * 64 + t) * LDZ + Z_Q + h_ * 128 + d0; Q[j] = *(const u32x4*)qp_; K[j] = *(const u32x4*)(qp_ + (Z_K - Z_Q)); GG[j] = glrg[(size_t)n_ * 1024 + i]; } \
        _Pragma("unroll") for (int j = 0; j < 4; ++j) { const int i = tid + j * 512, s_ = i >> 5, v0 = (i & 31) * 8; V[j] = *(const u32x4*)(z + (size_t)(n_ * 64 + s_) * LDZ + Z_V + h_ * 256 + v0); WW[j] = wa2[(i >> 7) * 512 + h_ * 128 + (i & 127)]; } } while (0)
    if ((int)blockIdx.x < 4 * NCH) GLA_LOAD((int)blockIdx.x, qpre, kpre, vpre, cg, cw);
    for (int unit = blockIdx.x; unit < 4 * NCH; unit += gridDim.x) { const int h = unit & 3, n = unit >> 2;
#pragma unroll
        for (int j = 0; j < 2; ++j) glrL[tid + j * 512] = cg[j];
#pragma unroll
        for (int j = 0; j < 4; ++j) waL[tid + j * 512] = cw[j];
        __syncthreads();
        const int nu = unit + (int)gridDim.x; const bool has_next = nu < 4 * NCH;
        if (has_next) GLA_LOAD(nu, nq, nk, nv, ng, nw4);
        gla_gates(A->in[17] + l * 512, h, lds, tid);
#pragma unroll
        for (int j = 0; j < 2; ++j) { const int i = tid + j * 512, t = i >> 4, d0 = (i & 15) * 8; bf16* qp = z + (size_t)(n * 64 + t) * LDZ + Z_Q + h * 128 + d0; bf16* kp = qp + (Z_K - Z_Q);
            const u32x4 qv = qpre[j], kv = kpre[j]; const unsigned qa[4] = {qv.x, qv.y, qv.z, qv.w}, ka[4] = {kv.x, kv.y, kv.z, kv.w}; unsigned qo[4], ko[4];
#pragma unroll
            for (int e = 0; e < 4; ++e) { const float b0 = bL[t * 128 + d0 + 2 * e], b1 = bL[t * 128 + d0 + 2 * e + 1], bl0 = bL[63 * 128 + d0 + 2 * e], bl1 = bL[63 * 128 + d0 + 2 * e + 1];
                const float e0 = __expf(b0), e1 = __expf(b1), k0 = blo(ka[e]), k1 = bhi(ka[e]);
                qo[e] = pk2(blo(qa[e]) * 0.08838834764831845f * e0, bhi(qa[e]) * 0.08838834764831845f * e1); ko[e] = pk2(k0 * __expf(-b0), k1 * __expf(-b1));
                k2T[(d0 + 2 * e) * 72 + ((t + d0) & 63)] = (bf16)f2bf(k0 * __expf(bl0 - b0)); k2T[(d0 + 2 * e + 1) * 72 + ((t + d0) & 63)] = (bf16)f2bf(k1 * __expf(bl1 - b1)); }
            u32x4 qw; qw.x = qo[0]; qw.y = qo[1]; qw.z = qo[2]; qw.w = qo[3]; u32x4 kw; kw.x = ko[0]; kw.y = ko[1]; kw.z = ko[2]; kw.w = ko[3];
            *(u32x4*)qp = qw; *(u32x4*)kp = kw; }
#pragma unroll
        for (int j = 0; j < 4; ++j) { const int i = tid + j * 512, s = i >> 5, v0 = (i & 31) * 8; const u32x4 vv = vpre[j];
            const unsigned va[4] = {vv.x, vv.y, vv.z, vv.w};
#pragma unroll
            for (int e = 0; e < 4; ++e) { vT[(v0 + 2 * e) * 72 + ((s + v0) & 63)] = (bf16)(va[e] & 0xffffu); vT[(v0 + 2 * e + 1) * 72 + ((s + v0) & 63)] = (bf16)(va[e] >> 16); } }
        if (tid < 128) dec[(size_t)(n * 4 + h) * 128 + tid] = __expf(bL[63 * 128 + tid]);
        __syncthreads();
#pragma unroll
        for (int j = 0; j < 4; ++j) { const int i = tid + j * 512, v = i >> 3, c = i & 7; *(u32x4*)(z + vt_off(n, h, v) + 8 * c) = *(const u32x4*)(vT + v * 72 + ((8 * c + 8 * (v >> 3)) & 63)); }
        f32x4 acc[2][8];
#pragma unroll
        for (int i = 0; i < 2; ++i)
#pragma unroll
            for (int j = 0; j < 8; ++j) acc[i][j] = (f32x4){0.f, 0.f, 0.f, 0.f};
#pragma unroll
        for (int kk = 0; kk < 2; ++kk) { bf16x8 a[2];
#pragma unroll
            for (int mt = 0; mt < 2; ++mt) { const int vr = wave * 32 + mt * 16 + r; a[mt] = ld8(vT + vr * 72 + ((kk * 32 + q * 8 + 8 * (vr >> 3)) & 63)); }
#pragma unroll
            for (int nt = 0; nt < 8; ++nt) { const int dr = nt * 16 + r; const bf16x8 b = ld8(k2T + dr * 72 + ((kk * 32 + q * 8 + 8 * (dr >> 3)) & 63));
#pragma unroll
                for (int mt = 0; mt < 2; ++mt) acc[mt][nt] = mma(b, a[mt], acc[mt][nt]); } }
        bf16* st = (bf16*)ST + (size_t)(n * 4 + h) * 32768;
#pragma unroll
        for (int mt = 0; mt < 2; ++mt)
#pragma unroll
            for (int nt = 0; nt < 8; ++nt) { u32x2 w; w.x = pk2(acc[mt][nt][0], acc[mt][nt][1]); w.y = pk2(acc[mt][nt][2], acc[mt][nt][3]); *(u32x2*)(st + (size_t)(wave * 32 + mt * 16 + r) * 128 + nt * 16 + 4 * q) = w; }
        __syncthreads();
        if (has_next) {
#pragma unroll
            for (int j = 0; j < 2; ++j) { qpre[j] = nq[j]; kpre[j] = nk[j]; cg[j] = ng[j]; }
#pragma unroll
            for (int j = 0; j < 4; ++j) { vpre[j] = nv[j]; cw[j] = nw4[j]; } }
    }
#undef GLA_LOAD
}
__device__ __forceinline__ void scan_phase(const unsigned char* wl, float* ST, const float* dec, const float* E, bf16* Sb, unsigned char* lds) {
    const int tid = tid_opaque(), NGT = gridDim.x * 512;
    const int wave = __builtin_amdgcn_readfirstlane(tid >> 6), lane = tid & 63;
    const bool split = gridDim.x >= 160;
    const int g0 = split ? (int)blockIdx.x - 128 : (int)blockIdx.x, gstep = split ? 32 : (int)gridDim.x;
    if (g0 >= 0) { const float* A16 = (const float*)(wl + L_A16); float* X = (float*)lds;
      for (int g = g0; g < 32; g += gstep) { const float ar = A16[(g * 64 + lane) * 2], ai = A16[(g * 64 + lane) * 2 + 1]; float sr = 0.f, si = 0.f;
          const int k0 = wave * 128;
#pragma unroll 16
          for (int k = 0; k < 128; ++k) { const size_t o = ((size_t)(k0 + k) * 32 + g) * 128 + lane; const float er = E[o], ei = E[o + 64];
              const float nr = ar * sr - ai * si + er, ni = ar * si + ai * sr + ei; sr = nr; si = ni; }
          X[(wave * 64 + lane) * 2] = sr; X[(wave * 64 + lane) * 2 + 1] = si;
          float pr = ar, pi = ai;
#pragma unroll
          for (int j = 0; j < 7; ++j) { const float t0 = pr * pr - pi * pi, t1 = 2.0f * pr * pi; pr = t0; pi = t1; }
          __syncthreads();
          sr = 0.f; si = 0.f;
          for (int j = 0; j < wave; ++j) { const float lr = X[(j * 64 + lane) * 2], li = X[(j * 64 + lane) * 2 + 1]; const float nr = pr * sr - pi * si + lr, ni = pr * si + pi * sr + li; sr = nr; si = ni; }
#pragma unroll 16
          for (int k = 0; k < 128; ++k) { const size_t o = ((size_t)(k0 + k) * 32 + g) * 128 + lane; const float er = E[o], ei = E[o + 64]; Sb[o] = (bf16)f2bf(sr); Sb[o + 64] = (bf16)f2bf(si);
              const float nr = ar * sr - ai * si + er, ni = ar * si + ai * sr + ei; sr = nr; si = ni; }
          __syncthreads(); } }
    if (split) {
        if (blockIdx.x < 128) { const int e2 = blockIdx.x * 512 + tid, e = 2 * e2, h = e >> 15, d = e & 127; float S0 = 0.f, S1 = 0.f; const float* dp = dec + h * 128 + d; unsigned* sp = (unsigned*)ST + e2;
#pragma unroll 32
            for (int n = 0; n < NCH; ++n) { const unsigned u = sp[(size_t)n * 65536]; const float dc0 = dp[n * 512], dc1 = dp[n * 512 + 1]; sp[(size_t)n * 65536] = pk2(S0, S1); S0 = dc0 * S0 + blo(u); S1 = dc1 * S1 + bhi(u); } }
    } else {
        for (int e = blockIdx.x * 512 + tid; e < 131072; e += NGT) { const int h = e >> 15, d = e & 127; float S = 0.f; const float* dp = dec + h * 128 + d; bf16* sp = (bf16*)ST + e;
#pragma unroll 32
            for (int n = 0; n < NCH; ++n) { const float kv = bf2f(sp[(size_t)n * 131072]); const float dc = dp[n * 512]; sp[(size_t)n * 131072] = (bf16)f2bf(S); S = dc * S + kv; } }
    }
}
__device__ __forceinline__ void gla_phase_c(KArgs A, int l, const bf16* z, const float* ST, bf16* mixed, unsigned char* lds) {
    const int tid = tid_opaque(), lane = tid & 63, wave = __builtin_amdgcn_readfirstlane(tid >> 6), r = lane & 15, q = lane >> 4;
    bf16* sc = (bf16*)lds; float* red = (float*)(lds + 9216);
    const float* gnw = A->in[18] + l * 256;
    for (int unit = blockIdx.x; unit < 4 * NCH; unit += gridDim.x) { const int h = unit & 3, n = unit >> 2;
        const bf16* qbase = z + (size_t)(n * 64 + r) * LDZ + Z_Q + h * 128 + q * 8; const bf16* kbase = qbase + (Z_K - Z_Q);
        const int tm = wave & 3, vh = wave >> 2; const size_t tok = (size_t)(n * 64 + tm * 16 + r);
        bf16x8 vfr[2][8]; u32x2 rpre[8];
#pragma unroll
        for (int kk = 0; kk < 2; ++kk)
#pragma unroll
            for (int nt = 0; nt < 8; ++nt) vfr[kk][nt] = ld8(z + vt_off(n, h, vh * 128 + nt * 16 + r) + kk * 32 + q * 8);
#pragma unroll
        for (int nt = 0; nt < 8; ++nt) rpre[nt] = *(const u32x2*)(z + tok * LDZ + Z_R + h * 256 + vh * 128 + nt * 16 + 4 * q);
#pragma unroll
        for (int ti = 0; ti < 2; ++ti) { const int id = wave * 2 + ti, tm = id >> 2, tn = id & 3; f32x4 acc = (f32x4){0.f, 0.f, 0.f, 0.f};
            if (tn <= tm) {
#pragma unroll
                for (int kk = 0; kk < 4; ++kk) acc = mma(ld8(kbase + (size_t)(tn * 16) * LDZ + kk * 32), ld8(qbase + (size_t)(tm * 16) * LDZ + kk * 32), acc); }
            const int t = tm * 16 + r, s0 = tn * 16 + 4 * q; u32x2 w; w.x = pk2(s0 <= t ? acc[0] : 0.f, s0 + 1 <= t ? acc[1] : 0.f); w.y = pk2(s0 + 2 <= t ? acc[2] : 0.f, s0 + 3 <= t ? acc[3] : 0.f);
            *(u32x2*)(sc + t * 72 + s0) = w; }
        __syncthreads();
        f32x4 acc[8];
#pragma unroll
        for (int i = 0; i < 8; ++i) acc[i] = (f32x4){0.f, 0.f, 0.f, 0.f};
#pragma unroll
        for (int kk = 0; kk < 2; ++kk) { const bf16x8 a = ld8(sc + (tm * 16 + r) * 72 + kk * 32 + q * 8);
#pragma unroll
            for (int nt = 0; nt < 8; ++nt) acc[nt] = mma(vfr[kk][nt], a, acc[nt]); }
        const bf16* st = (const bf16*)ST + (size_t)(n * 4 + h) * 32768;
#pragma unroll
        for (int kk = 0; kk < 4; ++kk) { const bf16x8 a = ld8(qbase + (size_t)(tm * 16) * LDZ + kk * 32);
#pragma unroll
            for (int nt = 0; nt < 8; ++nt) acc[nt] = mma(ld8(st + (size_t)(vh * 128 + nt * 16 + r) * 128 + kk * 32 + q * 8), a, acc[nt]); }
        float ss = 0.f;
#pragma unroll
        for (int nt = 0; nt < 8; ++nt) ss += (acc[nt][0] * acc[nt][0] + acc[nt][1] * acc[nt][1]) + (acc[nt][2] * acc[nt][2] + acc[nt][3] * acc[nt][3]);
        ss += __shfl_xor(ss, 16); ss += __shfl_xor(ss, 32);
        if (q == 0) red[vh * 64 + tm * 16 + r] = ss;
        __syncthreads();
        const float rstd = rsqrtf((red[tm * 16 + r] + red[64 + tm * 16 + r]) * (1.0f / 256.0f) + EPS);
#pragma unroll
        for (int nt = 0; nt < 8; ++nt) { const int v = vh * 128 + nt * 16 + 4 * q; const f32x4 nw = *(const f32x4*)(gnw + v); const u32x2 rv = rpre[nt];
            const float r0 = blo(rv.x), r1 = bhi(rv.x), r2 = blo(rv.y), r3 = bhi(rv.y);
            const float o0 = acc[nt][0] * rstd * nw[0] * r0 * __builtin_amdgcn_rcpf(1.0f + __expf(-r0)), o1 = acc[nt][1] * rstd * nw[1] * r1 * __builtin_amdgcn_rcpf(1.0f + __expf(-r1)),
                        o2 = acc[nt][2] * rstd * nw[2] * r2 * __builtin_amdgcn_rcpf(1.0f + __expf(-r2)), o3 = acc[nt][3] * rstd * nw[3] * r3 * __builtin_amdgcn_rcpf(1.0f + __expf(-r3));
            u32x2 w; w.x = pk2(o0, o1); w.y = pk2(o2, o3); *(u32x2*)(mixed + tok * D + 1024 + h * 256 + v) = w; }
        __syncthreads();
    }
}
__device__ __forceinline__ void fixup_panel(const float* cw, const float* cb, const float* headg, const float* headv, const float* tailg, bf16* act, int pm, int tid) {
    constexpr int F4 = DFF / 4; const f32x4 zero = (f32x4){0.f, 0.f, 0.f, 0.f};
    for (int c = tid; c < F4; c += 512) { const int f = 4 * c;
        const f32x4 w0 = *(const f32x4*)(cw + f), w1 = *(const f32x4*)(cw + DFF + f), w2 = *(const f32x4*)(cw + 2 * DFF + f), bb = *(const f32x4*)(cb + f);
        f32x4 hg0[4], hg1[4], hv0[4], hv1[4], t0[4], t1[4];
#pragma unroll
        for (int gq = 0; gq < 4; ++gq) { const int G = pm * 4 + gq; const size_t h0 = ((size_t)G * 2) * DFF + f, h1 = h0 + DFF;
            hg0[gq] = *(const f32x4*)(headg + h0); hg1[gq] = *(const f32x4*)(headg + h1); hv0[gq] = *(const f32x4*)(headv + h0); hv1[gq] = *(const f32x4*)(headv + h1);
            t0[gq] = G > 0 ? *(const f32x4*)(tailg + ((size_t)(G - 1) * 2) * DFF + f) : zero; t1[gq] = G > 0 ? *(const f32x4*)(tailg + ((size_t)(G - 1) * 2 + 1) * DFF + f) : zero; }
#pragma unroll
        for (int gq = 0; gq < 4; ++gq) { const int G = pm * 4 + gq;
            const f32x4 ga = bb + w0 * t0[gq] + w1 * t1[gq] + w2 * hg0[gq], gb = bb + w0 * t1[gq] + w1 * hg0[gq] + w2 * hg1[gq]; float a[4], b[4];
#pragma unroll
            for (int j = 0; j < 4; ++j) { a[j] = ga[j] * __builtin_amdgcn_rcpf(1.0f + __expf(-ga[j])) * hv0[gq][j]; b[j] = gb[j] * __builtin_amdgcn_rcpf(1.0f + __expf(-gb[j])) * hv1[gq][j]; }
            u32x2 wa; wa.x = pk2(a[0], a[1]); wa.y = pk2(a[2], a[3]); *(u32x2*)(act + (size_t)(G * 64) * DFF + f) = wa;
            u32x2 wb; wb.x = pk2(b[0], b[1]); wb.y = pk2(b[2], b[3]); *(u32x2*)(act + (size_t)(G * 64 + 1) * DFF + f) = wb; }
    }
}
__device__ __forceinline__ void final_phase(float* out, const float* sq, const float* fw, int gw, int NGW, int lane) {
    f32x4 w[8];
#pragma unroll
    for (int j = 0; j < 8; ++j) w[j] = *((const f32x4*)fw + lane + 64 * j);
    for (int m = gw; m < M; m += 2 * NGW) { const int m2 = (m + NGW < M) ? m + NGW : m; f32x4* xr = (f32x4*)(out + (size_t)m * D) + lane; f32x4* xr2 = (f32x4*)(out + (size_t)m2 * D) + lane;
        const float rs = rsqrtf(sq[m] * (1.0f / D) + EPS), rs2 = rsqrtf(sq[m2] * (1.0f / D) + EPS); f32x4 v[8], v2[8];
#pragma unroll
        for (int j = 0; j < 8; ++j) { v[j] = xr[64 * j]; v2[j] = xr2[64 * j]; }
#pragma unroll
        for (int j = 0; j < 8; ++j) { xr[64 * j] = v[j] * rs * w[j]; if (m2 != m) xr2[64 * j] = v2[j] * rs2 * w[j]; } }
}
#define LAS __attribute__((address_space(3)))
#define XB_TMO      128
#define XB_XCNT(j)  (256  + 64 * (j))
#define XB_XSUB(j)  (1280 + 64 * (j))
#define XB_XGEN(j)  (2304 + 64 * (j))
#define XB_TOP      3328
#define XB_TOPGEN   3392
#define XCD_BAR_WORDS 3456
#define XB_SPIN_CAP (1u << 18)

__device__ __forceinline__ unsigned xb_ld(unsigned* p)              { return __hip_atomic_load(p, __ATOMIC_RELAXED, __HIP_MEMORY_SCOPE_AGENT); }
__device__ __forceinline__ unsigned xb_add(unsigned* p, unsigned v) { return __hip_atomic_fetch_add(p, v, __ATOMIC_RELAXED, __HIP_MEMORY_SCOPE_AGENT); }
__device__ __forceinline__ unsigned xb_xcc_id() { return (unsigned)__builtin_amdgcn_s_getreg((3 << 11) | 20) & 0xFu; }
#define XB_SPIN(cond, bar) do { unsigned _sp = 0; while (cond) { __builtin_amdgcn_s_sleep(1); \
    if ((++_sp & 255u) == 0u) { if (xb_ld(&(bar)[XB_TMO])) break; if (_sp > XB_SPIN_CAP) { atomicAdd(&(bar)[XB_TMO], 1u); break; } } } } while (0)

struct XcdBarrier {
    unsigned* bar; unsigned x;
    volatile LAS unsigned* st;
};

__device__ __forceinline__ XcdBarrier xcd_barrier_post(unsigned* bar, volatile LAS unsigned* st) {
    XcdBarrier b; b.bar = bar; b.x = xb_xcc_id(); b.st = st;
    if (threadIdx.x == 0) (void)xb_add(&bar[XB_XCNT(b.x)], 1u);
    return b;
}
__device__ __forceinline__ void xcd_barrier_complete(unsigned* bar, unsigned x, unsigned& nloc, unsigned& nx) {
    const unsigned G = gridDim.x * gridDim.y * gridDim.z;
    unsigned sum, cnt, mine, sp = 0u;
    for (;;) {
        sum = 0u; cnt = 0u; mine = 0u;
#pragma unroll
        for (unsigned j = 0; j < 16; ++j) { const unsigned c = xb_ld(&bar[XB_XCNT(j)]); sum += c; cnt += (c > 0u) ? 1u : 0u; mine = (j == x) ? c : mine; }
        if (sum == G) break;
        __builtin_amdgcn_s_sleep(1);
        if ((++sp & 255u) == 0u) { if (xb_ld(&bar[XB_TMO])) break; if (sp > XB_SPIN_CAP) { atomicAdd(&bar[XB_TMO], 1u); break; } }
    }
    nloc = mine > 0u ? mine : 1u; nx = cnt > 0u ? cnt : 1u;
}

__device__ __forceinline__ void xcd_barrier(const XcdBarrier& b) {
    asm volatile("s_waitcnt vmcnt(0)" ::: "memory");
    __syncthreads();
    if (threadIdx.x == 0) {
        unsigned* bar = b.bar;
        __builtin_amdgcn_s_waitcnt(0);
        unsigned nloc = b.st[0], nx = b.st[1];
        if (nloc == 0u) { xcd_barrier_complete(bar, b.x, nloc, nx); b.st[0] = nloc; b.st[1] = nx; }
        const unsigned old = xb_add(&bar[XB_XSUB(b.x)], 1u);
        const unsigned gen = old / nloc;
        if (old + 1u == (gen + 1u) * nloc) {
            __builtin_amdgcn_fence(__ATOMIC_RELEASE, "agent");
            asm volatile("s_waitcnt vmcnt(0)" ::: "memory");
            (void)xb_add(&bar[XB_TOP], 1u);
        }
        XB_SPIN(xb_ld(&bar[XB_TOP]) < (gen + 1u) * nx, bar);
        __builtin_amdgcn_fence(__ATOMIC_ACQUIRE, "agent");
        asm volatile("s_waitcnt vmcnt(0)" ::: "memory");
    }
    __syncthreads();
}

struct FixedOrder : pg8::StaticOrder { __host__ __device__ bool next(int i, pg8::Unit& u) const { const bool ok = pg8::StaticOrder::next(i, u); u.pm = 0; u.pn = 0; return ok; } };
template <int PH, bool REP = false> __device__ __forceinline__ void run_phase(unsigned char* lds) {
    pg8::PG8_LAS_T ldsl = (pg8::PG8_LAS_T)lds;
    const int tid = tid_opaque(), lane = tid & 63, wave = __builtin_amdgcn_readfirstlane(tid >> 6);
    const int G = gridDim.x, gw = blockIdx.x * 8 + wave, NGW = G * 8;
    KArgs A = (KArgs)__builtin_amdgcn_kernarg_segment_ptr(); asm volatile("" : "+s"(A));
    unsigned char* ws = A->ws; asm volatile("" : "+s"(ws));
    float* sq = (float*)(ws + WS_SQ); bf16* mixed = (bf16*)(ws + WS_MIX); bf16* z = (bf16*)(ws + WS_Z);
    float* ST = (float*)(ws + WS_ST); float* E = (float*)(ws + WS_E); bf16* Sb = (bf16*)(ws + WS_SB); bf16* ybuf = (bf16*)(ws + WS_Y); float* dec = (float*)(ws + WS_DEC);
    bf16* act = (bf16*)(ws + WS_ACT); float* headg = (float*)(ws + WS_HEADG); float* headv = (float*)(ws + WS_HEADV); float* tailg = (float*)(ws + WS_TAILG);
    if constexpr (PH == 0) { if (EN(10)) phase_prologue(A, lds); }
    else if constexpr (PH == NPHASE - 1) { if (EN(11)) final_phase(A->out, sq + 6 * M, A->in[28], gw, NGW, lane); }
    else {
        constexpr int l = (PH - 1) / 9, sp = (PH - 1) % 9; unsigned char* wl = ws + WS_L0 + (size_t)l * WS_LSTRIDE;
        const float* sq_mix = sq + (size_t)(3 * l) * M; float* sq_ffn = sq + (size_t)(3 * l + 1) * M; float* sq_ple = sq + (size_t)(3 * l + 2) * M; float* sq_nxt = sq + (size_t)(3 * l + 3) * M;
        bf16* hb_cur = (bf16*)(ws + (l == 0 ? WS_HB : WS_HB2)); bf16* hb_alt = (bf16*)(ws + (l == 0 ? WS_HB2 : WS_HB));
        pg8::StaticOrder S;
        if constexpr (sp == 0) { if (EN(0)) { pg8::Gemm g{hb_cur, (const bf16*)(wl + L_WIN), M, LDZ, D}; S.init(M, LDZ, G, (int)blockIdx.x); pg8::EpiScaleBf16 Ep{z, LDZ, sq_mix, 1.0f / D};
                  pg8::gemm_phase<pg8::EpiScaleBf16, pg8::StaticOrder, true, true>(ldsl, g, S, Ep);
                  glr_phase(wl, hb_cur, sq_mix, (float*)(ws + WS_GLR), gw, NGW, lane); } }
        else if constexpr (sp == 1) { constexpr int sub = REP ? REPSUB : SUB; if (EN(1)) { if (sub & 1) s5_phase_a(wl, z, E, lds); if ((sub & 4) && !REP) gla_phase_a(A, l, z, (const float*)(ws + WS_GLR), ST, dec, lds); } }
        else if constexpr (sp == 2) { if (EN(2)) { scan_phase(wl, ST, dec, E, Sb, lds); pool_phase(wl, z, A->in[15] + l * 512, mixed, (unsigned*)(ws + WS_CNT) + 64 * l, lane); } }
        else if constexpr (sp == 3) { constexpr int sub = REP ? REPSUB : SUB; if (EN(3)) { if (sub & 1) s5_phase_c(wl, z, Sb, A->in[11] + l * 512, ybuf, lds); if (sub & 2) gla_phase_c(A, l, z, ST, mixed, lds); } }
        else if constexpr (sp == 4) { if (EN(4)) { pg8::Gemm g{ybuf, (const bf16*)(wl + L_WGLU), M, 512, 512}; S.init(M, 512, G, (int)blockIdx.x); pg8::EpiGlu Ep{ybuf, A->in[13] + l * 512, mixed};
                  pg8::gemm_phase<pg8::EpiGlu, pg8::StaticOrder, true, true>(ldsl, g, S, Ep); } }
        else if constexpr (sp == 5) { if (EN(5)) { pg8::Gemm g{mixed, (const bf16*)(wl + L_WOUT), M, D, D}; S.init(M, D, G, (int)blockIdx.x); pg8::EpiRes Ep{l == 0 ? A->in[0] : A->out, A->out, hb_alt, sq_ffn};
                  pg8::gemm_phase<pg8::EpiRes, pg8::StaticOrder, true, true>(ldsl, g, S, Ep); } }
        else if constexpr (sp == 6) { if (EN(6)) { pg8::Gemm g{hb_alt, (const bf16*)(wl + L_WUP), M, NUP, D}; S.init(M, NUP, G, (int)blockIdx.x);
#ifdef PROBE_NULL_EPI
                  if constexpr (REP) { pg8::EpiNull En;
#ifdef PROBE_FIXED_TILE
                      FixedOrder SF; SF.init(M, NUP, G, (int)blockIdx.x); pg8::gemm_phase<pg8::EpiNull, FixedOrder, true, true>(ldsl, g, SF, En);
#else
                      pg8::gemm_phase<pg8::EpiNull, pg8::StaticOrder, true, true>(ldsl, g, S, En);
#endif
                  } else
#endif
                  {
                  pg8::EpiUp Ep{act, sq_ffn, A->in[22] + (size_t)l * 3 * DFF, A->in[23] + l * DFF, headg, headv, tailg};
                  pg8::gemm_phase<pg8::EpiUp, pg8::StaticOrder, true, true>(ldsl, g, S, Ep); } } }
        else if constexpr (sp == 7) { if (EN(7)) {
                  { int Kp = PLED; asm volatile("" : "+s"(Kp)); pg8::Gemm g{(const bf16*)(ws + WS_PB) + (size_t)l * M * PLED, (const bf16*)(wl + L_WPLE), M, D, Kp}; S.init(M, D, G, (int)blockIdx.x); pg8::EpiScaleBf16 Ep{mixed, D, nullptr, 0.f};
                    pg8::gemm_phase<pg8::EpiScaleBf16, pg8::StaticOrder, true, true>(ldsl, g, S, Ep); }
                  S.init(M, D, G, (int)blockIdx.x);
                  { pg8::Unit u; int last = -1; for (int i = 0; S.next(i, u); ++i) { if (u.pm != last) fixup_panel(A->in[22] + (size_t)l * 3 * DFF, A->in[23] + l * DFF, headg, headv, tailg, act, u.pm, tid); last = u.pm; } }
                  asm volatile("s_waitcnt vmcnt(0)" ::: "memory"); __syncthreads();
                  { pg8::Gemm g{act, (const bf16*)(wl + L_WDN), M, D, DFF}; pg8::EpiRes Ep{A->out, A->out, hb_cur, sq_ple};
                    pg8::gemm_phase<pg8::EpiRes, pg8::StaticOrder, true, true>(ldsl, g, S, Ep); } } }
        else { if (EN(8)) { pg8::Gemm g{hb_cur, (const bf16*)(wl + L_WPG), M, D, D}; S.init(M, D, G, (int)blockIdx.x); pg8::EpiPg Ep{A->out, A->out, hb_alt, sq_nxt, sq_ple, mixed};
                  pg8::gemm_phase<pg8::EpiPg, pg8::StaticOrder, true, true>(ldsl, g, S, Ep); } }
    }
}
__global__ void __launch_bounds__(512, 2) hymba_fwd(Args args) {
    extern __shared__ __attribute__((aligned(16))) unsigned char lds[];
    const int lo = args.ph_lo, hi = args.ph_hi;
    volatile LAS unsigned* misc = (volatile LAS unsigned*)((LAS unsigned char*)lds + (LDS_BYTES - 64));
    if (threadIdx.x < 16) misc[threadIdx.x] = 0u;
    __syncthreads();
    const XcdBarrier bar = xcd_barrier_post((unsigned*)(args.ws + WS_BAR), misc);
    if (hi > 1000) cg::this_grid().sync();
#ifndef REPEAT_MASK
#define REPEAT_MASK 0
#endif
#define REPBIT(k) ((k) == 0 ? 10 : ((k) == NPHASE - 1 ? 11 : ((k) - 1) % 9))
#define RUN(k) if (lo <= (k) && (k) < hi) { if ((k) != lo) xcd_barrier(bar); run_phase<(k)>(lds); if ((REPEAT_MASK >> REPBIT(k)) & 1) { xcd_barrier(bar); run_phase<(k), true>(lds); } }
    RUN(0) RUN(1) RUN(2) RUN(3) RUN(4) RUN(5) RUN(6) RUN(7) RUN(8) RUN(9) RUN(10)
    RUN(11) RUN(12) RUN(13) RUN(14) RUN(15) RUN(16) RUN(17) RUN(18) RUN(19)
#undef RUN
}

#ifndef N_LAUNCH_MODE
#define N_LAUNCH_MODE 0
#endif
extern "C" void kernel_launch(void* const* d_in, const int* in_sizes, int n_in, void* d_out, int out_size, void* d_ws, size_t ws_size, hipStream_t stream) {
    static int grid = 0;
    if (grid == 0) {
        if (n_in != 29 || out_size != M * D || ws_size < WS_END) { fprintf(stderr, "kernel_launch: unexpected shapes (n_in %d out %d ws %zu need %zu)\n", n_in, out_size, ws_size, (size_t)WS_END); grid = -1; return; }
        int dev = 0, cus = 0, per_cu = 0;
        if (hipGetDevice(&dev) != hipSuccess || hipDeviceGetAttribute(&cus, hipDeviceAttributeMultiprocessorCount, dev) != hipSuccess) { grid = -1; return; }
        if (hipFuncSetAttribute((const void*)hymba_fwd, hipFuncAttributeMaxDynamicSharedMemorySize, LDS_BYTES) != hipSuccess) { fprintf(stderr, "kernel_launch: hipFuncSetAttribute failed\n"); grid = -1; return; }
        if (hipOccupancyMaxActiveBlocksPerMultiprocessor(&per_cu, (const void*)hymba_fwd, 512, LDS_BYTES) != hipSuccess || per_cu < 1) { fprintf(stderr, "kernel_launch: occupancy query says %d\n", per_cu); per_cu = 1; }
        (void)hipGetLastError();
        grid = cus * per_cu;
    }
    if (grid < 0) return;
    if (hipMemsetAsync((char*)d_ws + WS_BAR, 0, 16384 + 1024, stream) != hipSuccess) { fprintf(stderr, "kernel_launch: memset failed\n"); return; }
    Args a{};
    for (int i = 0; i < 29; ++i) a.in[i] = (const float*)d_in[i];
    a.out = (float*)d_out; a.ws = (unsigned char*)d_ws;
#if N_LAUNCH_MODE == 1
    for (int ph = 0; ph < NPHASE; ++ph) { a.ph_lo = ph; a.ph_hi = ph + 1; hipLaunchKernelGGL(hymba_fwd, dim3(grid), dim3(512), LDS_BYTES, stream, a); }
#else
    a.ph_lo = 0; a.ph_hi = NPHASE;
    void* kargs[] = {&a};
    hipError_t e = hipLaunchCooperativeKernel((const void*)hymba_fwd, dim3(grid), dim3(512), kargs, LDS_BYTES, stream);
    if (e != hipSuccess) fprintf(stderr, "kernel_launch: cooperative launch failed: %s (grid %d)\n", hipGetErrorString(e), grid);
#endif
}
```
